# Optimizing an MI355X kernel written in HIP

```python
import jax
import jax.numpy as jnp
from jax import lax
import numpy as np

D_MODEL = 1024
BATCH = 16
SEQ = 4096
DEPTH = 2

GRID_W = 64
CTX_LEN = 256
HEAD_DIM = 64
FOURIER_WIDTH = D_MODEL // 2
FOURIER_GROUPS = 4
FOURIER_GROUP_DIM = FOURIER_WIDTH // FOURIER_GROUPS
SWA_Q_HEADS = (D_MODEL // 2) // HEAD_DIM
SWA_KV_HEADS = SWA_Q_HEADS // 4
SWA_WINDOW = 128
SWA_BLOCK = 128
NA_HEADS = D_MODEL // HEAD_DIM
NA_ROWS_MAX = 8
NA_COLS = 16
N_EXPERTS = 16
EXPERT_FF = D_MODEL
EC_CAPACITY_FACTOR = 2
ROPE_BASE = 10000.0
EPS = 1e-6
N_EVEN = (DEPTH + 1) // 2
N_ODD = DEPTH // 2
EVEN_IN_WIDTH = FOURIER_WIDTH + (SWA_Q_HEADS + 2 * SWA_KV_HEADS) * HEAD_DIM
EVEN_OUT_WIDTH = FOURIER_WIDTH + SWA_Q_HEADS * HEAD_DIM
ODD_WIDTH = NA_HEADS * HEAD_DIM

kernel_name = 'hybrid_fourier_swa_natten_ecmoe_dit'


def rms_norm(x, gain):
    xf = x.astype(jnp.float32)
    y = xf * lax.rsqrt(jnp.mean(xf * xf, axis=-1, keepdims=True) + EPS)
    return (y * gain.astype(jnp.float32)).astype(x.dtype)


def modulate(h, shift, scale):
    return h * (1 + scale) + shift


def axial_rope(n_tokens):
    t = jnp.arange(n_tokens)
    row = (t // GRID_W).astype(jnp.float32)
    col = (t % GRID_W).astype(jnp.float32)
    n_freq = HEAD_DIM // 4
    inv_freq = jnp.power(ROPE_BASE, -jnp.arange(n_freq, dtype=jnp.float32) / n_freq)
    ang = jnp.concatenate([row[:, None] * inv_freq, col[:, None] * inv_freq], axis=-1)
    return jnp.cos(ang), jnp.sin(ang)


def apply_rope(x, cos, sin):
    xf = x.astype(jnp.float32)
    x1, x2 = jnp.split(xf, 2, axis=-1)
    c = cos[None, :, None, :]
    s = sin[None, :, None, :]
    return jnp.concatenate([x1 * c - x2 * s, x1 * s + x2 * c], axis=-1).astype(x.dtype)


def fourier_mix(u):
    y = jnp.fft.fft2(u.astype(jnp.float32), axes=(1, 3), norm='ortho')
    return jnp.real(y).astype(u.dtype)


def ctx_attention(q, k, v, sink):
    n_k = k.shape[1]
    s = jnp.einsum('bqhgd,bkhd->bhgqk', q, k).astype(jnp.float32) * (HEAD_DIM ** -0.5)
    if sink is not None:
        sk = jnp.broadcast_to(sink.astype(jnp.float32)[None, :, :, None, None], s.shape[:-1] + (1,))
        s = jnp.concatenate([s, sk], axis=-1)
    p = jax.nn.softmax(s, axis=-1)[..., :n_k].astype(v.dtype)
    return jnp.einsum('bhgqk,bkhd->bqhgd', p, v)


def swa_latent(q, k, v, k_ctx, v_ctx, sink):
    bsz, n, n_kv, grp, dh = q.shape
    n_ctx = k_ctx.shape[1]
    n_blk = n // SWA_BLOCK
    span = SWA_BLOCK + 2 * SWA_WINDOW
    pad = ((0, 0), (SWA_WINDOW, SWA_WINDOW), (0, 0), (0, 0))
    k_pad = jnp.pad(k, pad)
    v_pad = jnp.pad(v, pad)
    scale = HEAD_DIM ** -0.5
    sink_logit = jnp.broadcast_to(sink.astype(jnp.float32)[None, :, :, None, None],
                                  (bsz, n_kv, grp, SWA_BLOCK, 1))

    def block(i):
        q0 = i * SWA_BLOCK
        qb = lax.dynamic_slice_in_dim(q, q0, SWA_BLOCK, axis=1)
        kb = lax.dynamic_slice_in_dim(k_pad, q0, span, axis=1)
        vb = lax.dynamic_slice_in_dim(v_pad, q0, span, axis=1)
        s_ctx = jnp.einsum('bqhgd,bkhd->bhgqk', qb, k_ctx).astype(jnp.float32) * scale
        s_loc = jnp.einsum('bqhgd,bkhd->bhgqk', qb, kb).astype(jnp.float32) * scale
        q_pos = q0 + jnp.arange(SWA_BLOCK)
        k_pos = q0 - SWA_WINDOW + jnp.arange(span)
        valid = ((jnp.abs(q_pos[:, None] - k_pos[None, :]) <= SWA_WINDOW)
                 & (k_pos >= 0)[None, :] & (k_pos < n)[None, :])
        s_loc = jnp.where(valid, s_loc, -jnp.inf)
        p = jax.nn.softmax(jnp.concatenate([s_ctx, s_loc, sink_logit], axis=-1), axis=-1)
        p_ctx = p[..., :n_ctx].astype(v.dtype)
        p_loc = p[..., n_ctx:n_ctx + span].astype(v.dtype)
        return (jnp.einsum('bhgqk,bkhd->bqhgd', p_ctx, v_ctx)
                + jnp.einsum('bhgqk,bkhd->bqhgd', p_loc, vb))

    out = lax.map(block, jnp.arange(n_blk))
    return jnp.moveaxis(out, 0, 1).reshape(bsz, n, n_kv, grp, dh)


def na_latent(q, k, v, k_ctx, v_ctx, rpb):
    bsz, n, nh, dh = q.shape
    n_ctx = k_ctx.shape[1]
    rows = n // GRID_W
    kh = min(NA_ROWS_MAX, rows)
    kw = NA_COLS
    scale = HEAD_DIM ** -0.5
    q_g = q.reshape(bsz, rows, GRID_W, nh, dh)
    k_g = k.reshape(bsz, rows, GRID_W, nh, dh)
    v_g = v.reshape(bsz, rows, GRID_W, nh, dh)
    col_q = jnp.arange(GRID_W)
    col_k = jnp.arange(GRID_W)
    c_start = jnp.clip(col_q - kw // 2, 0, GRID_W - kw)
    col_valid = (col_k[None, :] >= c_start[:, None]) & (col_k[None, :] < c_start[:, None] + kw)
    dc_idx = jnp.clip(col_k[None, :] - col_q[:, None] + NA_COLS - 1, 0, 2 * NA_COLS - 2)
    rpb_f = rpb.astype(jnp.float32)

    def row_block(r):
        r_start = jnp.clip(r - kh // 2, 0, rows - kh)
        qb = lax.dynamic_index_in_dim(q_g, r, axis=1, keepdims=False)
        kb = lax.dynamic_slice_in_dim(k_g, r_start, kh, axis=1)
        vb = lax.dynamic_slice_in_dim(v_g, r_start, kh, axis=1)
        dr_idx = r_start + jnp.arange(kh) - r + NA_ROWS_MAX - 1
        bias = jnp.take(rpb_f, dr_idx, axis=1)[:, :, dc_idx]
        bias = jnp.transpose(bias, (0, 2, 1, 3))
        s_loc = jnp.einsum('bqhd,brkhd->bhqrk', qb, kb).astype(jnp.float32) * scale + bias
        s_loc = jnp.where(col_valid[:, None, :], s_loc, -jnp.inf).reshape(bsz, nh, GRID_W, kh * GRID_W)
        s_ctx = jnp.einsum('bqhd,bkhd->bhqk', qb, k_ctx).astype(jnp.float32) * scale
        p = jax.nn.softmax(jnp.concatenate([s_ctx, s_loc], axis=-1), axis=-1).astype(v.dtype)
        p_loc = p[..., n_ctx:].reshape(bsz, nh, GRID_W, kh, GRID_W)
        return (jnp.einsum('bhqk,bkhd->bqhd', p[..., :n_ctx], v_ctx)
                + jnp.einsum('bhqrk,brkhd->bqhd', p_loc, vb))

    out = lax.map(row_block, jnp.arange(rows))
    return jnp.moveaxis(out, 0, 1).reshape(bsz, n, nh, dh)


def expert_choice_ffn(h, w_router, w_gate, w_up, w_down):
    bsz, n, _ = h.shape
    cap = EC_CAPACITY_FACTOR * n // N_EXPERTS
    aff = jax.nn.softmax(jnp.einsum('bnd,de->bne', h, w_router).astype(jnp.float32), axis=-1)
    gate, idx = lax.top_k(jnp.swapaxes(aff, 1, 2), cap)
    b_idx = jnp.arange(bsz)[:, None, None]
    xs = h[b_idx, idx]
    a = jnp.einsum('becd,edf->becf', xs, w_gate)
    u = jnp.einsum('becd,edf->becf', xs, w_up)
    y = jnp.einsum('becf,efd->becd', jax.nn.silu(a) * u, w_down) * gate[..., None].astype(h.dtype)
    return jnp.zeros_like(h).at[b_idx, idx].add(y)


def split_heads(t, nh):
    return t.reshape(t.shape[0], t.shape[1], nh, HEAD_DIM)


def even_mixer(h_x, h_c, w_in, w_out, q_gain, k_gain, sink, cos, sin, ctx_out):
    bsz, n, _ = h_x.shape
    n_ctx = h_c.shape[1]
    dq = SWA_Q_HEADS * HEAD_DIM
    dkv = SWA_KV_HEADS * HEAD_DIM
    grp = SWA_Q_HEADS // SWA_KV_HEADS
    cuts = [FOURIER_WIDTH, FOURIER_WIDTH + dq, FOURIER_WIDTH + dq + dkv]
    sink_g = sink.reshape(SWA_KV_HEADS, grp)
    f_x, q_x, k_x, v_x = jnp.split(h_x @ w_in, cuts, axis=-1)
    q_x = apply_rope(rms_norm(split_heads(q_x, SWA_Q_HEADS), q_gain), cos, sin)
    k_x = apply_rope(rms_norm(split_heads(k_x, SWA_KV_HEADS), k_gain), cos, sin)
    v_x = split_heads(v_x, SWA_KV_HEADS)
    if ctx_out:
        f_c, q_c, k_c, v_c = jnp.split(h_c @ w_in, cuts, axis=-1)
    else:
        k_c, v_c = jnp.split(h_c @ w_in[:, FOURIER_WIDTH + dq:], [dkv], axis=-1)
    k_c = rms_norm(split_heads(k_c, SWA_KV_HEADS), k_gain)
    v_c = split_heads(v_c, SWA_KV_HEADS)
    a_x = swa_latent(q_x.reshape(bsz, n, SWA_KV_HEADS, grp, HEAD_DIM), k_x, v_x, k_c, v_c, sink_g)
    four_x = fourier_mix(f_x.reshape(bsz, n, FOURIER_GROUPS, FOURIER_GROUP_DIM))
    y_x = jnp.concatenate([four_x.reshape(bsz, n, FOURIER_WIDTH), a_x.reshape(bsz, n, dq)], axis=-1) @ w_out
    if not ctx_out:
        return y_x, None
    q_c = rms_norm(split_heads(q_c, SWA_Q_HEADS), q_gain).reshape(bsz, n_ctx, SWA_KV_HEADS, grp, HEAD_DIM)
    a_c = ctx_attention(q_c, k_c, v_c, sink_g)
    four_c = fourier_mix(f_c.reshape(bsz, n_ctx, FOURIER_GROUPS, FOURIER_GROUP_DIM))
    y_c = jnp.concatenate([four_c.reshape(bsz, n_ctx, FOURIER_WIDTH), a_c.reshape(bsz, n_ctx, dq)], axis=-1) @ w_out
    return y_x, y_c


def odd_mixer(h_x, h_c, w_in, w_out, q_gain, k_gain, rpb, ctx_out):
    bsz, n, _ = h_x.shape
    n_ctx = h_c.shape[1]
    q_x, k_x, v_x = jnp.split(h_x @ w_in, [ODD_WIDTH, 2 * ODD_WIDTH], axis=-1)
    q_x = rms_norm(split_heads(q_x, NA_HEADS), q_gain)
    k_x = rms_norm(split_heads(k_x, NA_HEADS), k_gain)
    v_x = split_heads(v_x, NA_HEADS)
    if ctx_out:
        q_c, k_c, v_c = jnp.split(h_c @ w_in, [ODD_WIDTH, 2 * ODD_WIDTH], axis=-1)
    else:
        k_c, v_c = jnp.split(h_c @ w_in[:, ODD_WIDTH:], [ODD_WIDTH], axis=-1)
    k_c = rms_norm(split_heads(k_c, NA_HEADS), k_gain)
    v_c = split_heads(v_c, NA_HEADS)
    a_x = na_latent(q_x, k_x, v_x, k_c, v_c, rpb)
    y_x = a_x.reshape(bsz, n, ODD_WIDTH) @ w_out
    if not ctx_out:
        return y_x, None
    q_c = rms_norm(split_heads(q_c, NA_HEADS), q_gain).reshape(bsz, n_ctx, NA_HEADS, 1, HEAD_DIM)
    a_c = ctx_attention(q_c, k_c, v_c, None)
    y_c = a_c.reshape(bsz, n_ctx, ODD_WIDTH) @ w_out
    return y_x, y_c


def setup_inputs(seed: int = 0) -> dict:
    key = jax.random.key(seed)
    ks = jax.random.split(key, 24)
    D = D_MODEL

    def nrm(k, shape, s):
        return jax.random.normal(k, shape, jnp.float32) * s

    return {
        'x': nrm(ks[0], (BATCH, SEQ, D), 1.0),
        'c': nrm(ks[1], (BATCH, D), 1.0),
        'ctx': nrm(ks[2], (BATCH, CTX_LEN, D), 1.0),
        'c_ctx': nrm(ks[3], (D,), 1.0),
        'ada_w': nrm(ks[4], (DEPTH, D, 6 * D), 0.5 * D ** -0.5),
        'ada_b': nrm(ks[5], (DEPTH, 6 * D), 0.02),
        'norm1_g': 1.0 + nrm(ks[6], (DEPTH, D), 0.05),
        'norm2_g': 1.0 + nrm(ks[7], (DEPTH, D), 0.05),
        'router_w': nrm(ks[8], (DEPTH, D, N_EXPERTS), D ** -0.5),
        'exp_w_gate': nrm(ks[9], (DEPTH, N_EXPERTS, D, EXPERT_FF), D ** -0.5),
        'exp_w_up': nrm(ks[10], (DEPTH, N_EXPERTS, D, EXPERT_FF), D ** -0.5),
        'exp_w_down': nrm(ks[11], (DEPTH, N_EXPERTS, EXPERT_FF, D), EXPERT_FF ** -0.5),
        'ev_w_in': nrm(ks[12], (N_EVEN, D, EVEN_IN_WIDTH), D ** -0.5),
        'ev_w_out': nrm(ks[13], (N_EVEN, EVEN_OUT_WIDTH, D), EVEN_OUT_WIDTH ** -0.5),
        'ev_q_gain': 1.0 + nrm(ks[14], (N_EVEN, HEAD_DIM), 0.05),
        'ev_k_gain': 1.0 + nrm(ks[15], (N_EVEN, HEAD_DIM), 0.05),
        'ev_sink': nrm(ks[16], (N_EVEN, SWA_Q_HEADS), 1.0),
        'od_w_in': nrm(ks[17], (N_ODD, D, 3 * ODD_WIDTH), D ** -0.5),
        'od_w_out': nrm(ks[18], (N_ODD, ODD_WIDTH, D), ODD_WIDTH ** -0.5),
        'od_q_gain': 1.0 + nrm(ks[19], (N_ODD, HEAD_DIM), 0.05),
        'od_k_gain': 1.0 + nrm(ks[20], (N_ODD, HEAD_DIM), 0.05),
        'od_rpb': nrm(ks[21], (N_ODD, NA_HEADS, 2 * NA_ROWS_MAX - 1, 2 * NA_COLS - 1), 0.1),
    }


def reference(x, c, ctx, c_ctx, ada_w, ada_b, norm1_g, norm2_g, router_w, exp_w_gate, exp_w_up,
              exp_w_down, ev_w_in, ev_w_out, ev_q_gain, ev_k_gain, ev_sink, od_w_in, od_w_out,
              od_q_gain, od_k_gain, od_rpb):
    n = x.shape[1]
    cos, sin = axial_rope(n)
    for layer in range(DEPTH):
        last = layer == DEPTH - 1
        j = layer // 2
        mod_x = jnp.split(jax.nn.silu(c) @ ada_w[layer] + ada_b[layer], 6, axis=-1)
        mod_c = jnp.split(jax.nn.silu(c_ctx) @ ada_w[layer] + ada_b[layer], 6, axis=-1)
        sh1, sc1, g1, sh2, sc2, g2 = [m[:, None, :] for m in mod_x]
        csh1, csc1, cg1, csh2, csc2, cg2 = mod_c
        h_x = modulate(rms_norm(x, norm1_g[layer]), sh1, sc1)
        h_c = modulate(rms_norm(ctx, norm1_g[layer]), csh1, csc1)
        if layer % 2 == 0:
            y_x, y_c = even_mixer(h_x, h_c, ev_w_in[j], ev_w_out[j], ev_q_gain[j], ev_k_gain[j],
                                  ev_sink[j], cos, sin, not last)
        else:
            y_x, y_c = odd_mixer(h_x, h_c, od_w_in[j], od_w_out[j], od_q_gain[j], od_k_gain[j],
                                 od_rpb[j], not last)
        x = x + g1 * y_x
        h_x = modulate(rms_norm(x, norm2_g[layer]), sh2, sc2)
        x = x + g2 * expert_choice_ffn(h_x, router_w[layer], exp_w_gate[layer], exp_w_up[layer],
                                       exp_w_down[layer])
        if not last:
            ctx = ctx + cg1 * y_c
            h_c = modulate(rms_norm(ctx, norm2_g[layer]), csh2, csc2)
            ctx = ctx + cg2 * expert_choice_ffn(h_c, router_w[layer], exp_w_gate[layer], exp_w_up[layer],
                                                exp_w_down[layer])
    return x
```

```cpp
#include <hip/hip_runtime.h>
#include <hip/hip_cooperative_groups.h>
#include <cstdio>
#include <cstdint>
namespace cg = cooperative_groups;

#define DI __device__ __forceinline__
#define LAS __attribute__((address_space(3)))
typedef unsigned short bf16_t;
typedef short bf16x8 __attribute__((ext_vector_type(8)));
typedef short s16x4 __attribute__((ext_vector_type(4)));
typedef float f32x4 __attribute__((ext_vector_type(4)));
typedef float f32x16 __attribute__((ext_vector_type(16)));
typedef unsigned u32x4 __attribute__((ext_vector_type(4)));
typedef unsigned u32x2 __attribute__((ext_vector_type(2)));
typedef float f32x2_t __attribute__((ext_vector_type(2)));
typedef __bf16 bf16x2_t __attribute__((ext_vector_type(2)));

DI int opaque_tid(int wid_s) { int l; asm volatile("v_mbcnt_lo_u32_b32 %0, -1, 0\n\tv_mbcnt_hi_u32_b32 %0, -1, %0" : "=v"(l)); asm volatile("" : "+s"(wid_s)); return (wid_s << 6) | l; }
DI unsigned pk2(float lo, float hi) { f32x2_t v = {lo, hi}; bf16x2_t b = __builtin_convertvector(v, bf16x2_t); return __builtin_bit_cast(unsigned, b); }
DI float shx(float v, int m, int lane) { return __int_as_float(__builtin_amdgcn_ds_bpermute((lane ^ m) << 2, __float_as_int(v))); }
DI float wave_sum(float v, int lane) {
#pragma unroll
    for (int o = 1; o < 64; o <<= 1) v += shx(v, o, lane);
    return v;
}

template <int CTRL> DI float dppf(float v) { return __int_as_float(__builtin_amdgcn_update_dpp(0, __float_as_int(v), CTRL, 0xF, 0xF, true)); }
DI float row16_sum(float v) { v += dppf<0xB1>(v); v += dppf<0x4E>(v); v += dppf<0x124>(v); v += dppf<0x128>(v); return v; }
DI float xrow_sum(float v) { auto r = __builtin_amdgcn_permlane16_swap(__float_as_uint(v), __float_as_uint(v), false, false); v = __uint_as_float(r[0]) + __uint_as_float(r[1]);
    auto q = __builtin_amdgcn_permlane32_swap(__float_as_uint(v), __float_as_uint(v), false, false); return __uint_as_float(q[0]) + __uint_as_float(q[1]); }
DI float xrow_max(float v) { auto r = __builtin_amdgcn_permlane16_swap(__float_as_uint(v), __float_as_uint(v), false, false); v = fmaxf(__uint_as_float(r[0]), __uint_as_float(r[1]));
    auto q = __builtin_amdgcn_permlane32_swap(__float_as_uint(v), __float_as_uint(v), false, false); return fmaxf(__uint_as_float(q[0]), __uint_as_float(q[1])); }
DI float wave_sum_fast(float v) { return xrow_sum(row16_sum(v)); }
DI float row16_max(float v) { v = fmaxf(v, dppf<0xB1>(v)); v = fmaxf(v, dppf<0x4E>(v)); v = fmaxf(v, dppf<0x124>(v)); v = fmaxf(v, dppf<0x128>(v)); return v; }
#ifndef REP_P0
#define REP_P0 1
#endif
#ifndef REP_N1
#define REP_N1 1
#endif
#ifndef REP_INP
#define REP_INP 1
#endif
#ifndef REP_MIX
#define REP_MIX 1
#endif
#ifndef REP_OUTP
#define REP_OUTP 1
#endif
#ifndef REP_N2
#define REP_N2 1
#endif
#ifndef REP_TOPK
#define REP_TOPK 1
#endif
#ifndef REP_MOE
#define REP_MOE 1
#endif
#ifndef REP_FOUR
#define REP_FOUR 1
#endif
#ifndef REP_SWA
#define REP_SWA 1
#endif
#ifndef REP_NA
#define REP_NA 1
#endif
#ifndef EXTRA_SYNCS
#define EXTRA_SYNCS 0
#endif
#ifndef PG8_ALIGN_EPI
#define PG8_ALIGN_EPI 1
#endif
#ifndef REP_EPI
#define REP_EPI 1
#endif
#ifndef N2_MFMA
#define N2_MFMA 2
#endif
constexpr int D = 1024, NB = 16, SEQ = 4096, LC = 256;
constexpr int NX = NB * SEQ, NC = NB * LC, NR = NX + NC;
constexpr int NE = 16, CAPX = 512, CAPC = 32;
constexpr int NSLOT_X = NB * NE * CAPX, NSLOT_C = NB * NE * CAPC, NSLOT = NSLOT_X + NSLOT_C;
constexpr float LOG2E = 1.4426950408889634f;
constexpr float QSCALE = 0.125f * LOG2E;

constexpr size_t MiB = 1u << 20;
constexpr size_t WS_WPR = 0, WS_WQKV0 = 2 * MiB, WS_WOUT0 = 4 * MiB, WS_WIN1 = 6 * MiB, WS_WOUT1 = 12 * MiB, WS_DFTC = 14 * MiB;
constexpr size_t WS_MOD = 15 * MiB, WS_ROPE = 16 * MiB, WS_AFF = 17 * MiB, WS_ROWIDX = 22 * MiB, WS_GATEV = 23 * MiB;
constexpr size_t WS_WGU = 24 * MiB, WS_WDN = 152 * MiB, WS_DFT = 216 * MiB, WS_CTX1 = 280 * MiB, WS_ACTV = 296 * MiB, WS_BIG = 432 * MiB;
constexpr size_t WS_QKV = WS_BIG, WS_PRT = WS_BIG + 104 * MiB, WS_PRTC = WS_BIG + 232 * MiB, WS_ACT = WS_BIG  , WS_Y = WS_BIG + 128 * MiB  , WS_INV = WS_BIG + 400 * MiB  ;
constexpr size_t WS_ACTC = WS_DFT  , WS_CNT = WS_GATEV + 768 * 1024  ;
constexpr size_t WS_CS = WS_MOD + 900 * 1024  ;
constexpr size_t WS_UV = WS_BIG + 240 * MiB  ;
constexpr size_t WS_BAR = WS_GATEV + 800 * 1024  ;
constexpr size_t WS_END = WS_BIG + 408 * MiB;

constexpr int LDS_BYTES = 147456, PT_OFF = LDS_BYTES - 256;
DI void* ldptr(LAS unsigned char* lds, int i) { int a_ = PT_OFF + 8 * i; asm volatile("" : "+v"(a_)); const unsigned long long v = *(LAS unsigned long long*)(lds + a_);
    const unsigned lo = __builtin_amdgcn_readfirstlane((unsigned)v), hi = __builtin_amdgcn_readfirstlane((unsigned)(v >> 32));
    return (void*)(__attribute__((address_space(1))) void*)(((unsigned long long)hi << 32) | lo); }

struct Params { const float* in[22]; float* out; unsigned char* ws; };

namespace pg8 {
constexpr int BM = 256, BK = 64, HALF = 128, HTB = HALF * BK * 2, STAGE_BYTES = 8 * HTB, NXCD = 8, WGM = 4;
DI int lds_byte(int r, int c) { const int st = (r >> 4) * 2 + (c >> 5), rr = r & 15, cc = c & 31, ob = rr * 64 + cc * 2; return st * 1024 + (ob ^ (((ob >> 9) & 1) << 5)); }
DI void stage_rc(int b, int& R, int& C) { const int st = b / 1024, sb = b % 1024, swz = sb ^ (((sb >> 9) & 1) << 5); R = (st >> 1) * 16 + swz / 64; C = (st & 1) * 32 + (swz % 64) / 2; }

DI int perm32(int rho) { const int n = rho >> 4, i = rho & 15; return 8 * (i >> 2) + 4 * n + (i & 3); }
struct Unit { int pm, pn; };
struct Gemm { const bf16_t* A; const bf16_t* Bt; int K; const int* gather; };

struct StaticOrder {
    int nM, nN, nwg, G, c, pm_off, pn_off;
    DI void init(int M, int N, int G_, int c_, int pmo = 0, int pno = 0) { nM = M / BM; nN = N / BM; nwg = nM * nN; G = G_; c = c_; pm_off = pmo; pn_off = pno; }
    DI bool next(int i, Unit& u) const {
        const long L = (long)i * G + c; if (L >= nwg) return false;
        int wgid = (int)L; { const int q = nwg / NXCD, r = nwg % NXCD, xcd = wgid % NXCD, off = wgid / NXCD; wgid = (xcd < r ? xcd * (q + 1) : r * (q + 1) + (xcd - r) * q) + off; }
        const int nig = WGM * nN, gid = wgid / nig, fm = gid * WGM, gsz = (nM - fm) < WGM ? (nM - fm) : WGM;
        u.pm = pm_off + fm + ((wgid % nig) % gsz); u.pn = pn_off + (wgid % nig) / gsz; return true;
    }
};
struct TileSched {
    int pm, pn0, nU;
    DI bool next(int i, Unit& u) const { if (i >= nU) return false; u.pm = pm; u.pn = pn0 + i; return true; }
};

template <class Epi, class Sched, bool SWAP, bool GATHER>
DI void gemm_phase(LAS unsigned char* lds, const Gemm g, const Sched& S, const Epi& E, int wid_s) {
    const int tid = opaque_tid(wid_s), wid = __builtin_amdgcn_readfirstlane(tid >> 6), lane = tid & 63, wr = wid >> 2, wc = wid & 3, fr = lane & 15, fq = lane >> 4;
    const int K = g.K, nt = K / BK;
    unsigned voffA0[2], voffA1[2], voffB[2];
#pragma unroll
    for (int i = 0; i < 2; ++i) { int R, C; stage_rc(tid * 16 + i * 8192, R, C);
        if constexpr (GATHER) { voffA0[i] = (unsigned)(g.gather[R] * K + C) * 2u; voffA1[i] = (unsigned)(g.gather[HALF + R] * K + C) * 2u; }
        else { voffA0[i] = (unsigned)(R * K + C) * 2u; voffA1[i] = voffA0[i]; }
        { const int Rb = Epi::PERM ? ((R & ~31) + perm32(R & 31)) : R; voffB[i] = (unsigned)(Rb * K + C) * 2u; } }
    const size_t kstep = (size_t)(BK * 2);
    const size_t hstep = (size_t)HALF * K * 2;
    const size_t tstep = 2 * hstep;
    const unsigned ldsw = (unsigned)wid * 1024u;
    const int aoff = lds_byte(wr * 64 + fr, fq * 8), boff = lds_byte(wc * 32 + fr, fq * 8);
#define PG8_SA(b, h) (((b) * 2 + (h)) * HTB)
#define PG8_SB(b, h) ((4 + (b) * 2 + (h)) * HTB)
#define PG8_STAGE(bufoff, gbase, voff) do { _Pragma("unroll") for (int _i = 0; _i < 2; ++_i) \
        __builtin_amdgcn_global_load_lds((const unsigned*)((const char*)(gbase) + (voff)[_i]), (LAS unsigned*)(lds + (bufoff) + ldsw + _i * 8192), 16, 0, 0); } while (0)
#define PG8_STAGE_A(bufoff, gbase, h) do { if constexpr (GATHER) { if (h) PG8_STAGE(bufoff, gbase, voffA1); else PG8_STAGE(bufoff, gbase, voffA0); } \
        else { PG8_STAGE(bufoff, (gbase) + (h) * hstep, voffA0); } } while (0)
#define PG8_LDA(dst, b, h) do { _Pragma("unroll") for (int m = 0; m < 4; ++m) _Pragma("unroll") for (int k = 0; k < 2; ++k) dst[m][k] = *(const LAS bf16x8*)(lds + PG8_SA(b, h) + aoff + m * 2048 + k * 1024); } while (0)
#define PG8_LDB(dst, b, h) do { _Pragma("unroll") for (int n = 0; n < 2; ++n) _Pragma("unroll") for (int k = 0; k < 2; ++k) dst[n][k] = *(const LAS bf16x8*)(lds + PG8_SB(b, h) + boff + n * 2048 + k * 1024); } while (0)
#define PG8_MMA(ai, bj, At, Bt) do { __builtin_amdgcn_s_setprio(1); _Pragma("unroll") for (int m = 0; m < 4; ++m) _Pragma("unroll") for (int n = 0; n < 2; ++n) _Pragma("unroll") for (int k = 0; k < 2; ++k) \
        acc[ai][bj][m][n] = SWAP ? __builtin_amdgcn_mfma_f32_16x16x32_bf16(At[m][k], Bt[n][k], acc[ai][bj][m][n], 0, 0, 0) \
                                 : __builtin_amdgcn_mfma_f32_16x16x32_bf16(Bt[n][k], At[m][k], acc[ai][bj][m][n], 0, 0, 0); __builtin_amdgcn_s_setprio(0); } while (0)
#define PG8_WAIT_V(n) asm volatile("s_waitcnt vmcnt(" #n ")" ::: "memory")
#define PG8_WAIT_L(n) asm volatile("s_waitcnt lgkmcnt(" #n ")" ::: "memory")
#define PG8_BAR __builtin_amdgcn_s_barrier()
#define PG8_SCHED __builtin_amdgcn_sched_barrier(0)
    Unit cur, nxt; int ui = 0;
    if (!S.next(0, cur)) return;
    f32x4 acc[2][2][4][2];
#pragma unroll
    for (int a = 0; a < 2; ++a)
#pragma unroll
        for (int b = 0; b < 2; ++b)
#pragma unroll
            for (int m = 0; m < 4; ++m)
#pragma unroll
                for (int n = 0; n < 2; ++n) acc[a][b][m][n] = (f32x4){0.f, 0.f, 0.f, 0.f};
    bf16x8 At[4][2], B0[2][2], B1[2][2];
    const char* cA = (const char*)g.A + (GATHER ? (size_t)0 : (size_t)cur.pm * tstep); const char* cB = (const char*)g.Bt + (size_t)cur.pn * tstep;
    PG8_STAGE(PG8_SB(0, 0), cB, voffB); PG8_STAGE(PG8_SB(0, 1), cB + hstep, voffB); PG8_STAGE_A(PG8_SA(0, 0), cA, 0); PG8_STAGE_A(PG8_SA(0, 1), cA, 1);
    if (wr == 1) PG8_BAR;
    PG8_WAIT_V(2); PG8_BAR;
    PG8_STAGE(PG8_SB(1, 0), cB + kstep, voffB); PG8_STAGE_A(PG8_SA(1, 0), cA + kstep, 0); PG8_STAGE(PG8_SB(1, 1), cB + hstep + kstep, voffB);
    PG8_WAIT_V(6); PG8_BAR;
    for (;;) {
        const bool has_next = S.next(ui + 1, nxt);
        const char* nA = has_next ? (const char*)g.A + (GATHER ? (size_t)0 : (size_t)nxt.pm * tstep) : cA; const char* nB = has_next ? (const char*)g.Bt + (size_t)nxt.pn * tstep : cB;
        for (int t = 0; t < nt; t += 2) {
            const bool last = (t == nt - 2);
            const char* a1 = cA + (size_t)(t + 1) * kstep;
            const char* a2 = last ? nA : cA + (size_t)(t + 2) * kstep; const char* b2 = last ? nB : cB + (size_t)(t + 2) * kstep;
            const char* a3 = a2 + kstep; const char* b3 = b2 + kstep;
            PG8_LDB(B0, 0, 0); PG8_LDB(B1, 0, 1); PG8_SCHED; PG8_LDA(At, 0, 0); PG8_STAGE_A(PG8_SA(1, 1), a1, 1);
            PG8_WAIT_V(8); PG8_WAIT_L(0); PG8_BAR; PG8_MMA(0, 0, At, B0); PG8_MMA(0, 1, At, B1); PG8_BAR; PG8_SCHED;
            PG8_LDA(At, 0, 1); PG8_STAGE(PG8_SB(0, 0), b2, voffB); PG8_STAGE(PG8_SB(0, 1), b2 + hstep, voffB); PG8_STAGE_A(PG8_SA(0, 0), a2, 0);
            PG8_WAIT_V(8); PG8_WAIT_L(0); PG8_BAR; PG8_MMA(1, 0, At, B0); PG8_MMA(1, 1, At, B1); PG8_BAR; PG8_SCHED;
            PG8_LDB(B0, 1, 0); PG8_LDB(B1, 1, 1); PG8_SCHED; PG8_LDA(At, 1, 0); PG8_STAGE_A(PG8_SA(0, 1), a2, 1);
            PG8_WAIT_V(8); PG8_WAIT_L(0); PG8_BAR; PG8_MMA(0, 0, At, B0); PG8_MMA(0, 1, At, B1); PG8_BAR; PG8_SCHED;
            PG8_LDA(At, 1, 1); PG8_STAGE(PG8_SB(1, 0), b3, voffB); PG8_STAGE(PG8_SB(1, 1), b3 + hstep, voffB); PG8_STAGE_A(PG8_SA(1, 0), a3, 0);
            PG8_WAIT_V(8); PG8_WAIT_L(0); PG8_BAR; PG8_MMA(1, 0, At, B0); PG8_MMA(1, 1, At, B1); PG8_BAR; PG8_SCHED;
        }
        if (PG8_ALIGN_EPI) { if (wr == 0) PG8_BAR; }
        if (REP_EPI == 1 || !Epi::IDEM) E(acc, cur, wr, wc, fr, fq);
        else { int nrep_ = REP_EPI; asm volatile("" : "+s"(nrep_)); _Pragma("nounroll") for (int re_ = 0; re_ < nrep_; ++re_) { E(acc, cur, wr, wc, fr, fq); asm volatile("" ::: "memory"); } }
        if (!has_next) break;
#pragma unroll
        for (int a = 0; a < 2; ++a)
#pragma unroll
            for (int b = 0; b < 2; ++b)
#pragma unroll
                for (int m = 0; m < 4; ++m)
#pragma unroll
                    for (int n = 0; n < 2; ++n) acc[a][b][m][n] = (f32x4){0.f, 0.f, 0.f, 0.f};
        cur = nxt; cA = nA; cB = nB; ++ui;
        if (PG8_ALIGN_EPI) { if (wr == 1) PG8_BAR; }
    }
    PG8_WAIT_V(0);
    if (!PG8_ALIGN_EPI) { if (wr == 0) PG8_BAR; }
    PG8_BAR;
#undef PG8_SA
#undef PG8_SB
#undef PG8_STAGE
#undef PG8_STAGE_A
#undef PG8_LDA
#undef PG8_LDB
#undef PG8_MMA
#undef PG8_WAIT_V
#undef PG8_WAIT_L
#undef PG8_BAR
#undef PG8_SCHED
}
}

typedef f32x4 AccT[2][2][4][2];

struct EpiPR {
    static constexpr bool PERM = false;
    static constexpr bool IDEM = true;
    bf16_t* prt; bf16_t* prtc;
    DI void operator()(const AccT& acc, const pg8::Unit& u, int wr, int wc, int fr, int fq) const {
        const bool isx = u.pm < NX / 256;
#pragma unroll
        for (int ai = 0; ai < 2; ++ai)
#pragma unroll
            for (int m = 0; m < 4; ++m) {
                const int row = u.pm * 256 + ai * 128 + wr * 64 + m * 16 + fq * 4;
#pragma unroll
                for (int bj = 0; bj < 2; ++bj)
#pragma unroll
                    for (int n = 0; n < 2; ++n) {
                        const int col = u.pn * 256 + bj * 128 + wc * 32 + n * 16 + fr;
                        const int part = col >> 9, gl = col & 511;
                        const f32x4 v = acc[ai][bj][m][n];
                        u32x2 w; w.x = pk2(v[0], v[1]); w.y = pk2(v[2], v[3]);
                        if (isx) { const int b = row >> 12, nn = row & 4095; *(u32x2*)(prt + ((size_t)((b * 2 + part) * 512 + gl) * 4096 + nn)) = w; }
                        else { const int rc = row - NX, b = rc >> 8, nn = rc & 255; *(u32x2*)(prtc + ((size_t)((b * 512 + gl) * 2 + part) * 256 + nn)) = w; }
                    }
            }
    }
};
template <int LAYER> struct EpiQKV {
    static constexpr bool PERM = true;
    static constexpr bool IDEM = true;
    bf16_t* qkv; const float* qg; const float* kg; const float* ropec; const float* ropes;
    DI void operator()(const AccT& acc, const pg8::Unit& u, int wr, int wc, int fr, int fq) const {
        constexpr int pitch = LAYER == 0 ? 768 : 3072;
        int kind;
        if (LAYER == 0) kind = u.pn < 2 ? 0 : (wc < 2 ? 1 : 2); else kind = u.pn < 4 ? 0 : (u.pn < 8 ? 1 : 2);
        const bool isx = u.pm < NX / 256;
        const bool rope = (LAYER == 0) && isx && kind < 2;
        f32x4 gv[2][2];
        if (kind < 2) { const float* gp = kind == 0 ? qg : kg;
#pragma unroll
            for (int bj = 0; bj < 2; ++bj)
#pragma unroll
                for (int n = 0; n < 2; ++n) gv[bj][n] = *(const f32x4*)(gp + bj * 32 + fq * 8 + n * 4); }
        const float osc = kind == 0 ? QSCALE : 1.f;
#pragma unroll
        for (int ai = 0; ai < 2; ++ai)
#pragma unroll
            for (int m = 0; m < 4; ++m) {
                const int row = u.pm * 256 + ai * 128 + wr * 64 + m * 16 + fr;
                f32x4 v[2][2];
#pragma unroll
                for (int bj = 0; bj < 2; ++bj)
#pragma unroll
                    for (int n = 0; n < 2; ++n) v[bj][n] = acc[ai][bj][m][n];
                if (kind < 2) {
                    float ss = 0.f;
#pragma unroll
                    for (int bj = 0; bj < 2; ++bj)
#pragma unroll
                        for (int n = 0; n < 2; ++n) { const f32x4 x = v[bj][n]; ss += (x[0] * x[0] + x[1] * x[1]) + (x[2] * x[2] + x[3] * x[3]); }
                    ss = xrow_sum(ss);
                    const float rstd = 1.0f / sqrtf(ss * (1.0f / 64.0f) + 1e-6f);
#pragma unroll
                    for (int bj = 0; bj < 2; ++bj)
#pragma unroll
                        for (int n = 0; n < 2; ++n) v[bj][n] = (v[bj][n] * rstd) * gv[bj][n];
                    if (rope) {
                        const int t = row & 4095;
#pragma unroll
                        for (int n = 0; n < 2; ++n) {
                            const f32x4 c = *(const f32x4*)(ropec + t * 32 + fq * 8 + n * 4), s = *(const f32x4*)(ropes + t * 32 + fq * 8 + n * 4);
                            const f32x4 x1 = v[0][n], x2 = v[1][n];
                            v[0][n] = x1 * c - x2 * s; v[1][n] = x1 * s + x2 * c;
                        }
                    }
                }
                bf16_t* op = qkv + (size_t)row * pitch + u.pn * 256 + wc * 64 + fq * 8;
#pragma unroll
                for (int bj = 0; bj < 2; ++bj) { const f32x4 x = v[bj][0] * osc, z = v[bj][1] * osc; u32x4 w; w.x = pk2(x[0], x[1]); w.y = pk2(x[2], x[3]); w.z = pk2(z[0], z[1]); w.w = pk2(z[2], z[3]); *(u32x4*)(op + bj * 32) = w; }
                if (m & 1) asm volatile("" ::: "memory");
            }
    }
};
struct EpiFourier {
    static constexpr bool PERM = true;
    static constexpr bool IDEM = true;
    bf16_t* att; int rowbase, rows_per_b;
    DI void operator()(const AccT& acc, const pg8::Unit& u, int wr, int wc, int fr, int fq) const {
        const int b = u.pn >> 1, colbase = (u.pn & 1) * 256 + wc * 32 + fq * 8;
#pragma unroll
        for (int ai = 0; ai < 2; ++ai)
#pragma unroll
            for (int m = 0; m < 4; ++m) {
                const int row = rowbase + b * rows_per_b + u.pm * 256 + ai * 128 + wr * 64 + m * 16 + fr;
                bf16_t* op = att + (size_t)row * D + colbase;
#pragma unroll
                for (int bj = 0; bj < 2; ++bj) { const f32x4 x = acc[ai][bj][m][0], y = acc[ai][bj][m][1]; u32x4 w; w.x = pk2(x[0], x[1]); w.y = pk2(x[2], x[3]); w.z = pk2(y[0], y[1]); w.w = pk2(y[2], y[3]); *(u32x4*)(op + bj * 128) = w; }
            }
    }
};
struct EpiUV {
    static constexpr int NVM = 0;
    static constexpr bool PERM = true;
    static constexpr bool IDEM = true;
    bf16_t* uv;
    DI void operator()(const AccT& acc, const pg8::Unit& u, int wr, int wc, int fr, int fq) const {
        const int bp = u.pn >> 1, colbase = (u.pn & 1) * 256 + wc * 32 + fq * 8, kt = u.pm & 7;
#pragma unroll
        for (int ai = 0; ai < 2; ++ai)
#pragma unroll
            for (int m = 0; m < 4; ++m) {
                const int k = kt * 256 + ai * 128 + wr * 64 + m * 16 + fr;
                bf16_t* op = uv + ((size_t)bp * 2048 + k) * 512 + colbase;
#pragma unroll
                for (int bj = 0; bj < 2; ++bj) { const f32x4 x = acc[ai][bj][m][0], y = acc[ai][bj][m][1]; u32x4 w; w.x = pk2(x[0], x[1]); w.y = pk2(x[2], x[3]); w.z = pk2(y[0], y[1]); w.w = pk2(y[2], y[3]); *(u32x4*)(op + bj * 128) = w; }
            }
    }
};
struct FourierSched {
    pg8::StaticOrder so;
    DI bool next(int i, pg8::Unit& u) const { if (!so.next(i, u)) return false; u.pm += 8 * ((u.pn >> 1) & 1); return true; }
};
struct EpiOut {
    static constexpr bool PERM = true;
    static constexpr bool IDEM = false;
    const float* xin; float* xout; const float* cin; float* cout; const float* mod;
    DI void operator()(const AccT& acc, const pg8::Unit& u, int wr, int wc, int fr, int fq) const {
        const bool isx = u.pm < NX / 256;
        const int col0 = u.pn * 256 + wc * 32 + fq * 8;
        const int s = isx ? (u.pm >> 4) : 16;
        const float* gp = mod + (size_t)s * 6144 + 2 * 1024 + col0;
        f32x4 gv[2][2];
#pragma unroll
        for (int bj = 0; bj < 2; ++bj)
#pragma unroll
            for (int n = 0; n < 2; ++n) gv[bj][n] = *(const f32x4*)(gp + bj * 128 + n * 4);
#pragma unroll
        for (int ai = 0; ai < 2; ++ai)
#pragma unroll
            for (int m = 0; m < 4; ++m) {
                const int row = u.pm * 256 + ai * 128 + wr * 64 + m * 16 + fr;
                const size_t off = isx ? (size_t)row * D + col0 : (size_t)(row - NX) * D + col0;
                const float* ip = (isx ? xin : cin) + off; float* op = (isx ? xout : cout) + off;
#pragma unroll
                for (int bj = 0; bj < 2; ++bj)
#pragma unroll
                    for (int n = 0; n < 2; ++n) { const f32x4 x = *(const f32x4*)(ip + bj * 128 + n * 4);
                        *(f32x4*)(op + bj * 128 + n * 4) = x + gv[bj][n] * acc[ai][bj][m][n]; }
            }
    }
};
struct EpiGU {
    static constexpr bool PERM = true;
    static constexpr bool IDEM = true;
    bf16_t* act;
    DI void operator()(const AccT& acc, const pg8::Unit& u, int wr, int wc, int fr, int fq) const {
#pragma unroll
        for (int ai = 0; ai < 2; ++ai)
#pragma unroll
            for (int m = 0; m < 4; ++m) {
                const int slot = u.pm * 256 + ai * 128 + wr * 64 + m * 16 + fr;
                bf16_t* op = act + (size_t)slot * D + u.pn * 128 + wc * 32 + fq * 8;
                f32x4 r[2];
#pragma unroll
                for (int n = 0; n < 2; ++n) { const f32x4 a = acc[ai][0][m][n], up = acc[ai][1][m][n];
#pragma unroll
                    for (int j = 0; j < 4; ++j) r[n][j] = a[j] * up[j] * __builtin_amdgcn_rcpf(1.0f + __expf(-a[j])); }
                { u32x4 w; w.x = pk2(r[0][0], r[0][1]); w.y = pk2(r[0][2], r[0][3]); w.z = pk2(r[1][0], r[1][1]); w.w = pk2(r[1][2], r[1][3]); *(u32x4*)op = w; }
            }
    }
};
struct EpiDown {
    static constexpr bool PERM = true;
    static constexpr bool IDEM = true;
    bf16_t* y; int slot0;
    DI void operator()(const AccT& acc, const pg8::Unit& u, int wr, int wc, int fr, int fq) const {
        const int col0 = u.pn * 256 + wc * 32 + fq * 8;
#pragma unroll
        for (int ai = 0; ai < 2; ++ai)
#pragma unroll
            for (int m = 0; m < 4; ++m) {
                const int slot = slot0 + ai * 128 + wr * 64 + m * 16 + fr;
                bf16_t* op = y + (size_t)slot * D + col0;
#pragma unroll
                for (int bj = 0; bj < 2; ++bj) { const f32x4 x = acc[ai][bj][m][0], z = acc[ai][bj][m][1]; u32x4 w; w.x = pk2(x[0], x[1]); w.y = pk2(x[2], x[3]); w.z = pk2(z[0], z[1]); w.w = pk2(z[2], z[3]); *(u32x4*)(op + bj * 128) = w; }
            }
    }
};

constexpr int AL_K = 0, AL_V = 32768, AL_WS = 65536, AL_OST = 67584, AL_RPB = 100352;
DI int crow(int r, int hi) { return (r & 3) + 8 * (r >> 2) + 4 * hi; }
#define MFMA32(a, b, c) __builtin_amdgcn_mfma_f32_32x32x16_bf16((a), (b), (c), 0, 0, 0)
typedef short v4i16_t __attribute__((ext_vector_type(4)));
DI s16x4 vtr(const LAS unsigned char* p) { return __builtin_bit_cast(s16x4, __builtin_amdgcn_ds_read_tr16_b64_v4i16((LAS v4i16_t*)p)); }

DI float score_bound(const float* qgain, const float* kgain, const float* rpb, int nrpb, const float* sinkp, int nsink, int lane) {
    float gq = fabsf(qgain[lane]), gk = fabsf(kgain[lane]); gq = xrow_max(row16_max(gq)); gk = xrow_max(row16_max(gk));
    float sb = 8.0f * gq * gk * (LOG2E * 1.02f), ex_ = 0.f;
    if (rpb) { float bm = 0.f; for (int i = lane; i < nrpb; i += 64) bm = fmaxf(bm, fabsf(rpb[i])); bm = xrow_max(row16_max(bm)); sb += bm * LOG2E; }
    if (sinkp) { float sm_ = lane < nsink ? fabsf(sinkp[lane]) : 0.f; ex_ = xrow_max(row16_max(sm_)) * LOG2E; }
    const bool ok = (sb <= 60.0f) && (ex_ <= 60.0f);
    return ok ? sb : -1.0f;
}
template <int MODE>
DI void attn_unit(int unit, const bf16_t* __restrict__ qkv, bf16_t* att, const float* sinkp, const float* rpb, float sbound, LAS unsigned char* lds, int wid_s) {
    const int tid = opaque_tid(wid_s), lane = tid & 63, r32 = lane & 31, hi = lane >> 5, wid = __builtin_amdgcn_readfirstlane(tid >> 6);
    constexpr int pitch = MODE == 2 ? 3072 : 768;
    int b, qrow, qcol, kcol, vcol, ocol, nT, loc0 = 0, head;
    int qblk = 0, r0 = 0, c0 = 0, qr_l = 0, rs_l = 0, qc = 0, cs = 0, rs_lo = 0, rs_hi = 0;
    if (MODE == 0) { b = unit >> 7; const int kvh = (unit >> 6) & 1; qblk = unit & 63; head = kvh * 4 + (wid >> 1);
        qrow = b * SEQ + qblk * 64 + 32 * (wid & 1) + r32; qcol = head * 64; kcol = 512 + kvh * 64; vcol = 640 + kvh * 64; ocol = 512 + head * 64;
        const int lo = qblk - 2 < 0 ? 0 : qblk - 2, hi_ = qblk + 2 > 63 ? 63 : qblk + 2; loc0 = lo; nT = 4 + (hi_ - lo + 1); }
    else if (MODE == 1) { b = unit >> 3; const int kvh = (unit >> 2) & 1, qb = unit & 3; head = kvh * 4 + (wid >> 1);
        qrow = NX + b * LC + qb * 64 + 32 * (wid & 1) + r32; qcol = head * 64; kcol = 512 + kvh * 64; vcol = 640 + kvh * 64; ocol = 512 + head * 64; nT = 4; }
    else { b = unit >> 8; head = (unit >> 4) & 15; const int i4 = unit & 15, jg = wid & 3; r0 = 4 * i4 + 2 * (wid >> 2);
        qr_l = r0 + (r32 >> 4); qc = 16 * jg + (r32 & 15);
        qrow = b * SEQ + 64 * qr_l + qc; qcol = head * 64; kcol = 1024 + head * 64; vcol = 2048 + head * 64; ocol = head * 64;
        int lo = 4 * i4 - 4; lo = lo < 0 ? 0 : (lo > 56 ? 56 : lo); int h2 = 4 * i4 - 1; h2 = h2 < 0 ? 0 : (h2 > 56 ? 56 : h2); loc0 = lo; nT = 4 + (h2 + 7 - lo + 1);
        c0 = 16 * jg - 8; c0 = c0 < 0 ? 0 : (c0 > 32 ? 32 : c0);
        rs_l = qr_l - 4; rs_l = rs_l < 0 ? 0 : (rs_l > 56 ? 56 : rs_l);
        rs_lo = r0 - 4; rs_lo = rs_lo < 0 ? 0 : (rs_lo > 56 ? 56 : rs_lo); rs_hi = r0 - 3; rs_hi = rs_hi < 0 ? 0 : (rs_hi > 56 ? 56 : rs_hi);
        cs = qc - 8; cs = cs < 0 ? 0 : (cs > 48 ? 48 : cs); }
    const int ctxrow0 = NX + b * LC;
    auto tile_row = [&](int t) -> int { return t < 4 ? ctxrow0 + 64 * t : b * SEQ + 64 * (loc0 + t - 4); };
    const int lkey = tid >> 3, lc = tid & 7;
    const int kdst = lc * 1024 + lkey * 16, vdst = ((lc >> 2) * 4 + (lkey >> 4)) * 1024 + (lkey & 15) * 64 + (lc & 3) * 16;
    LAS float* wsf = (LAS float*)(lds + AL_WS) + wid * 64;
    LAS float* rpbl = (LAS float*)(lds + AL_RPB);
    unsigned boff[4] = {0u, 0u, 0u, 0u};
    if (MODE == 2) { { const int rr_ = tid >> 5, cc_ = tid & 31; rpbl[tid] = (rr_ < 15 && cc_ < 31) ? rpb[head * 465 + rr_ * 31 + cc_] * LOG2E : -INFINITY; }
#pragma unroll
        for (int i = 0; i < 16; ++i) { const int kc = c0 + crow(i, hi); int ix = kc - qc + 15; ix = ix < 0 ? 0 : (ix > 30 ? 30 : ix); boff[i >> 2] |= (unsigned)((((unsigned)(kc - cs) < 16u) ? ix : 31) * 4) << (8 * (i & 3)); } }
    const int nS = (nT + 1) >> 1;
    u32x4 kA[2], vA[2], kB[2], vB[2];
    auto issue_loads = [&](int step, u32x4 (&kr_)[2], u32x4 (&vr_)[2]) {
#pragma unroll
        for (int sb = 0; sb < 2; ++sb) { int tt = 2 * step + sb; tt = tt < nT ? tt : nT - 1; const bf16_t* src = qkv + (size_t)(tile_row(tt) + lkey) * pitch + lc * 8; kr_[sb] = *(const u32x4*)(src + kcol); vr_[sb] = *(const u32x4*)(src + vcol); } };
    auto write_lds = [&](int step, const u32x4 (&kr_)[2], const u32x4 (&vr_)[2]) { const int nb = (step & 1) * 16384;
#pragma unroll
        for (int sb = 0; sb < 2; ++sb) { *(LAS u32x4*)(lds + AL_K + nb + sb * 8192 + kdst) = kr_[sb]; *(LAS u32x4*)(lds + AL_V + nb + sb * 8192 + vdst) = vr_[sb]; } };
    issue_loads(0, kA, vA);
    if (nS > 1) issue_loads(1, kB, vB);
    bf16x8 qr[4];
#pragma unroll
    for (int d0 = 0; d0 < 4; ++d0) qr[d0] = *(const bf16x8*)(qkv + (size_t)qrow * pitch + qcol + d0 * 16 + hi * 8);
    write_lds(0, kA, vA);
    f32x16 o0, o1;
#pragma unroll
    for (int i = 0; i < 16; ++i) { o0[i] = 0.f; o1[i] = 0.f; }
    float mref = 0.f, lsum = 0.f;
    const bool fast = __builtin_amdgcn_readfirstlane(sbound >= 0.f ? 1 : 0) != 0;
    if (fast) mref = sbound;
    const int qoff = 32 * (wid & 1) + r32;
    const int i16 = lane & 15, vrd = (4 * hi + (i16 >> 2)) * 64 + ((lane >> 4) & 1) * 32 + (i16 & 3) * 8;
    int vlo2 = 0, vhi2 = 0;
    if (MODE == 2) { const int k0_ = c0 + 4 * hi + (i16 >> 2), k1_ = k0_ + 8; const int bo = ((lane >> 4) & 1) * 32 + (i16 & 3) * 8;
        vlo2 = (k0_ >> 4) * 1024 + (k0_ & 15) * 64 + bo; vhi2 = (k1_ >> 4) * 1024 + (k1_ & 15) * 64 + bo; }
#define ATT_RESCALE(rm_, delta_) do { delta_ = 0.f; if (t == 0) { delta_ = (rm_); mref = (rm_); } else if (__any((rm_) > 8.0f)) { \
        delta_ = fmaxf((rm_), 0.f); const float f = __builtin_amdgcn_exp2f(-delta_); lsum *= f; mref += delta_; \
        if (hi == 0) wsf[r32] = f; \
        asm volatile("s_waitcnt lgkmcnt(0)" ::: "memory"); \
        _Pragma("unroll") for (int i = 0; i < 16; ++i) { const float fr_ = wsf[crow(i, hi)]; o0[i] *= fr_; o1[i] *= fr_; } \
        asm volatile("s_waitcnt lgkmcnt(0)" ::: "memory"); } } while (0)
    auto compute_step = [&](int st) {
#pragma unroll 1
        for (int sub = 0; sub < 2; ++sub) {
        const int t = 2 * st + sub;
        if (t >= nT) break;
        bool active = true; int kr = 0;
        if (MODE == 2 && t >= 4) { kr = loc0 + t - 4; active = (kr >= rs_lo) && (kr < rs_hi + 8); }
        if (active) {
            const LAS unsigned char* Kb = lds + AL_K + (st & 1) * 16384 + sub * 8192; const LAS unsigned char* Vb = lds + AL_V + (st & 1) * 16384 + sub * 8192;
            if (MODE == 2 && t >= 4) {
                f32x16 p0; const float nm = -mref;
#pragma unroll
                for (int i = 0; i < 16; ++i) p0[i] = nm;
#pragma unroll
                for (int d0 = 0; d0 < 4; ++d0) { const bf16x8 k0 = *(const LAS bf16x8*)(Kb + (2 * d0 + hi) * 1024 + (c0 + r32) * 16); p0 = MFMA32(k0, qr[d0], p0); }
                { int dr = kr - qr_l + 7; dr = ((unsigned)(kr - rs_l) < 8u) ? (dr < 0 ? 0 : (dr > 14 ? 14 : dr)) : 15; const LAS unsigned char* bp = lds + AL_RPB + dr * 128;
#pragma unroll
                  for (int i = 0; i < 16; ++i) p0[i] += *(const LAS float*)(bp + ((boff[i >> 2] >> (8 * (i & 3))) & 0xffu)); }
                if (!fast) {
                float rm = p0[0];
#pragma unroll
                for (int i = 1; i < 16; ++i) rm = fmaxf(rm, p0[i]);
                { auto r_ = __builtin_amdgcn_permlane32_swap(__float_as_uint(rm), __float_as_uint(rm), false, false); rm = fmaxf(__uint_as_float(r_[0]), __uint_as_float(r_[1])); }
                float dl; ATT_RESCALE(rm, dl);
                if (__any(dl != 0.f)) {
#pragma unroll
                    for (int i = 0; i < 16; ++i) p0[i] -= dl; }
                }
                f32x2_t ls2 = (f32x2_t){0.f, 0.f};
#pragma unroll
                for (int i = 0; i < 16; i += 2) { p0[i] = __builtin_amdgcn_exp2f(p0[i]); p0[i + 1] = __builtin_amdgcn_exp2f(p0[i + 1]); ls2 += (f32x2_t){p0[i], p0[i + 1]}; }
                lsum += ls2[0] + ls2[1];
#pragma unroll
                for (int ks = 0; ks < 2; ++ks) {
                    u32x4 w; w.x = pk2(p0[8 * ks + 0], p0[8 * ks + 1]); w.y = pk2(p0[8 * ks + 2], p0[8 * ks + 3]); w.z = pk2(p0[8 * ks + 4], p0[8 * ks + 5]); w.w = pk2(p0[8 * ks + 6], p0[8 * ks + 7]);
                    const bf16x8 pa = __builtin_bit_cast(bf16x8, w);
#pragma unroll
                    for (int d0 = 0; d0 < 2; ++d0) {
                        const s16x4 lo = vtr(Vb + d0 * 4096 + ks * 1024 + vlo2), hh = vtr(Vb + d0 * 4096 + ks * 1024 + vhi2);
                        const bf16x8 vf = (bf16x8){lo[0], lo[1], lo[2], lo[3], hh[0], hh[1], hh[2], hh[3]};
                        if (d0 == 0) o0 = MFMA32(pa, vf, o0); else o1 = MFMA32(pa, vf, o1);
                    }
                }
            } else {
            f32x16 p0, p1; const float nm = -mref;
#pragma unroll
            for (int i = 0; i < 16; ++i) { p0[i] = nm; p1[i] = nm; }
#pragma unroll
            for (int d0 = 0; d0 < 4; ++d0) {
                const bf16x8 k0 = *(const LAS bf16x8*)(Kb + (2 * d0 + hi) * 1024 + r32 * 16), k1 = *(const LAS bf16x8*)(Kb + (2 * d0 + hi) * 1024 + r32 * 16 + 512);
                p0 = MFMA32(k0, qr[d0], p0); p1 = MFMA32(k1, qr[d0], p1);
            }
            if (MODE == 0 && t >= 4) {
                const int kt = loc0 + t - 4;
                if (kt == qblk - 2) {
#pragma unroll
                    for (int i = 0; i < 16; ++i) { const int key = crow(i, hi); if (key < qoff) p0[i] = -INFINITY; if (key + 32 < qoff) p1[i] = -INFINITY; }
                } else if (kt == qblk + 2) {
#pragma unroll
                    for (int i = 0; i < 16; ++i) { const int key = crow(i, hi); if (key > qoff) p0[i] = -INFINITY; if (key + 32 > qoff) p1[i] = -INFINITY; }
                }
            }
            if (!fast) {
            float rm = fmaxf(p0[0], p1[0]);
#pragma unroll
            for (int i = 1; i < 16; ++i) rm = fmaxf(rm, fmaxf(p0[i], p1[i]));
            { auto r_ = __builtin_amdgcn_permlane32_swap(__float_as_uint(rm), __float_as_uint(rm), false, false); rm = fmaxf(__uint_as_float(r_[0]), __uint_as_float(r_[1])); }
            float dl; ATT_RESCALE(rm, dl);
            if (__any(dl != 0.f)) {
#pragma unroll
                for (int i = 0; i < 16; ++i) { p0[i] -= dl; p1[i] -= dl; } }
            }
            f32x2_t ls2 = (f32x2_t){0.f, 0.f};
#pragma unroll
            for (int i = 0; i < 16; ++i) { p0[i] = __builtin_amdgcn_exp2f(p0[i]); p1[i] = __builtin_amdgcn_exp2f(p1[i]); ls2 += (f32x2_t){p0[i], p1[i]}; }
            lsum += ls2[0] + ls2[1];
            bf16x8 pa[4];
#pragma unroll
            for (int ks = 0; ks < 4; ++ks) {
                u32x4 w;
                if (ks < 2) { w.x = pk2(p0[8 * ks + 0], p0[8 * ks + 1]); w.y = pk2(p0[8 * ks + 2], p0[8 * ks + 3]); w.z = pk2(p0[8 * ks + 4], p0[8 * ks + 5]); w.w = pk2(p0[8 * ks + 6], p0[8 * ks + 7]); }
                else { const int k2 = ks - 2; w.x = pk2(p1[8 * k2 + 0], p1[8 * k2 + 1]); w.y = pk2(p1[8 * k2 + 2], p1[8 * k2 + 3]); w.z = pk2(p1[8 * k2 + 4], p1[8 * k2 + 5]); w.w = pk2(p1[8 * k2 + 6], p1[8 * k2 + 7]); }
                pa[ks] = __builtin_bit_cast(bf16x8, w);
            }
#pragma unroll
            for (int ks = 0; ks < 4; ++ks) {
#pragma unroll
                for (int d0 = 0; d0 < 2; ++d0) {
                    const LAS unsigned char* vp = Vb + (d0 * 4 + ks) * 1024 + vrd;
                    const s16x4 lo = vtr(vp), hh = vtr(vp + 512);
                    const bf16x8 vf = (bf16x8){lo[0], lo[1], lo[2], lo[3], hh[0], hh[1], hh[2], hh[3]};
                    if (d0 == 0) o0 = MFMA32(pa[ks], vf, o0); else o1 = MFMA32(pa[ks], vf, o1);
                }
            }
            }
        }
        }
    };
    for (int st = 0; st < nS; st += 2) {
        __syncthreads();
        if (st + 2 < nS) issue_loads(st + 2, kA, vA);
        compute_step(st);
        if (st + 1 < nS) {
            write_lds(st + 1, kB, vB);
            __syncthreads();
            if (st + 3 < nS) issue_loads(st + 3, kB, vB);
            compute_step(st + 1);
            if (st + 2 < nS) write_lds(st + 2, kA, vA);
        }
    }
#undef ATT_RESCALE
    { auto r_ = __builtin_amdgcn_permlane32_swap(__float_as_uint(lsum), __float_as_uint(lsum), false, false); lsum = __uint_as_float(r_[0]) + __uint_as_float(r_[1]); }
    if (MODE != 2) lsum += __builtin_amdgcn_exp2f(sinkp[head] * LOG2E - mref);
    const float inv = 1.0f / lsum;
    if (hi == 0) wsf[32 + r32] = inv;
    asm volatile("s_waitcnt lgkmcnt(0)" ::: "memory");
    LAS bf16_t* stg = (LAS bf16_t*)(lds + AL_OST) + wid * 2048;
#pragma unroll
    for (int i = 0; i < 16; ++i) { const int orow = crow(i, hi); const float iv = wsf[32 + orow];
        stg[orow * 64 + r32] = (bf16_t)(pk2(o0[i] * iv, 0.f) & 0xffffu); stg[orow * 64 + 32 + r32] = (bf16_t)(pk2(o1[i] * iv, 0.f) & 0xffffu); }
    asm volatile("s_waitcnt lgkmcnt(0)" ::: "memory");
    const int qrow_w = qrow - r32 * (MODE == 2 ? 0 : 1);
#pragma unroll
    for (int i = 0; i < 4; ++i) { const int row = i * 8 + (lane >> 3), ch = lane & 7; const u32x4 v = *(const LAS u32x4*)(stg + row * 64 + ch * 8);
        size_t tok;
        if (MODE == 2) tok = (size_t)b * SEQ + 64 * (r0 + (row >> 4)) + 16 * (wid & 3) + (row & 15); else tok = (size_t)qrow_w + row;
        *(u32x4*)(att + tok * D + ocol + ch * 8) = v; }
    __syncthreads();
}

#define XB_TMO      128
#define XB_XCNT(j)  (256  + 64 * (j))
#define XB_XSUB(j)  (1280 + 64 * (j))
#define XB_XGEN(j)  (2304 + 64 * (j))
#define XB_TOP      3328
#define XB_TOPGEN   3392
#define XCD_BAR_WORDS 3456
#define XB_SPIN_CAP (1u << 22)
DI unsigned xb_ld(unsigned* p)              { return __hip_atomic_load(p, __ATOMIC_RELAXED, __HIP_MEMORY_SCOPE_AGENT); }
DI unsigned xb_add(unsigned* p, unsigned v) { return __hip_atomic_fetch_add(p, v, __ATOMIC_RELAXED, __HIP_MEMORY_SCOPE_AGENT); }
DI unsigned xb_xcc_id() { return (unsigned)__builtin_amdgcn_s_getreg((3 << 11) | 20) & 0xFu; }
#define XB_SPIN(cond, bar) do { unsigned _sp = 0; while (cond) { __builtin_amdgcn_s_sleep(1); \
    if ((++_sp & 255u) == 0u) { if (xb_ld(&(bar)[XB_TMO])) break; if (_sp > XB_SPIN_CAP) { atomicAdd(&(bar)[XB_TMO], 1u); break; } } } } while (0)
DI void xcd_barrier_complete(unsigned* bar, unsigned x, unsigned& nloc, unsigned& nx) {
    const unsigned G = gridDim.x * gridDim.y * gridDim.z;
    unsigned sum, cnt, mine, sp = 0u;
    for (;;) {
        sum = 0u; cnt = 0u; mine = 0u;
#pragma unroll
        for (unsigned j = 0; j < 16; ++j) { const unsigned c = xb_ld(&bar[XB_XCNT(j)]); sum += c; cnt += (c > 0u) ? 1u : 0u; mine = (j == x) ? c : mine; }
        if (sum == G) break;
        __builtin_amdgcn_s_sleep(1);
        if ((++sp & 255u) == 0u) { if (xb_ld(&bar[XB_TMO])) break; if (sp > XB_SPIN_CAP) { atomicAdd(&bar[XB_TMO], 1u); break; } }
    }
    nloc = mine > 0u ? mine : 1u; nx = cnt > 0u ? cnt : 1u;
}
DI void xcd_barrier(unsigned* bar, volatile LAS unsigned* st) {
    asm volatile("s_waitcnt vmcnt(0)" ::: "memory");
    __syncthreads();
    if (threadIdx.x == 0) {
        const unsigned x = xb_xcc_id();
        __builtin_amdgcn_s_waitcnt(0);
        unsigned nloc = st[0], nx = st[1];
        if (nloc == 0u) { xcd_barrier_complete(bar, x, nloc, nx); st[0] = nloc; st[1] = nx; }
        const unsigned old = xb_add(&bar[XB_XSUB(x)], 1u);
        const unsigned gen = old / nloc;
        if (old + 1u == (gen + 1u) * nloc) {
            __builtin_amdgcn_fence(__ATOMIC_RELEASE, "agent");
            asm volatile("s_waitcnt vmcnt(0)" ::: "memory");
            const unsigned og = xb_add(&bar[XB_TOP], 1u);
            const unsigned tg = og / nx;
            if (og + 1u == (tg + 1u) * nx) xb_add(&bar[XB_TOPGEN], 1u);
            else XB_SPIN(xb_ld(&bar[XB_TOPGEN]) == tg, bar);
            __builtin_amdgcn_fence(__ATOMIC_ACQUIRE, "agent");
            xb_add(&bar[XB_XGEN(x)], 1u);
            asm volatile("s_waitcnt vmcnt(0)" ::: "memory");
        } else {
            XB_SPIN(xb_ld(&bar[XB_XGEN(x)]) == gen, bar);
            __builtin_amdgcn_fence(__ATOMIC_ACQUIRE, "agent");
            asm volatile("s_waitcnt vmcnt(0)" ::: "memory");
        }
    }
    __syncthreads();
}

DI void transpose_item(const float* W, int ldw, int k0, int n0, bf16_t* WT, int drowA, int drowB, LAS float* scr, int lane) {
    const int n4 = (lane & 15) * 4, kr = lane >> 4;
    f32x4 v[16];
#pragma unroll
    for (int i = 0; i < 16; ++i) v[i] = *(const f32x4*)(W + (size_t)(k0 + 4 * i + kr) * ldw + n0 + n4);
#pragma unroll
    for (int i = 0; i < 16; ++i) { LAS float* d = scr + (4 * i + kr) * 65 + n4; d[0] = v[i][0]; d[1] = v[i][1]; d[2] = v[i][2]; d[3] = v[i][3]; }
    asm volatile("s_waitcnt lgkmcnt(0)" ::: "memory");
    const int c = lane & 7;
#pragma unroll
    for (int j = 0; j < 8; ++j) { const int n = (lane >> 3) + 8 * j; const LAS float* s = scr + (8 * c) * 65 + n;
        u32x4 o; o.x = pk2(s[0 * 65], s[1 * 65]); o.y = pk2(s[2 * 65], s[3 * 65]); o.z = pk2(s[4 * 65], s[5 * 65]); o.w = pk2(s[6 * 65], s[7 * 65]);
        const int drow = n < 32 ? drowA + n : drowB + n - 32;
        *(u32x4*)(WT + (size_t)drow * 1024 + k0 + 8 * c) = o; }
    asm volatile("s_waitcnt lgkmcnt(0)" ::: "memory");
}
DI int headslot_row(int n) { const int hs = n >> 6, d0 = n & 63, pn = hs >> 2, wc = hs & 3, bj = d0 >> 5; return 256 * pn + 128 * bj + 32 * wc; }

DI int block_excl_scan(int v, LAS int* wsum, int lane, int wid, int& total) {
    int inc = v;
#pragma unroll
    for (int o = 1; o < 64; o <<= 1) { const int t = __builtin_amdgcn_ds_bpermute(((lane - o) & 63) << 2, inc); if (lane >= o) inc += t; }
    if (lane == 63) wsum[wid] = inc;
    __syncthreads();
    int base = 0, tot = 0;
#pragma unroll
    for (int w = 0; w < 8; ++w) { const int x = wsum[w]; tot += x; if (w < wid) base += x; }
    total = tot;
    __syncthreads();
    return base + inc - v;
}

DI void router_softmax_store(const float (&lg)[16], int lane, float* dst, bool doit) {
    float a8[8], a4[4];
#pragma unroll
    for (int i = 0; i < 8; ++i) { auto r = __builtin_amdgcn_permlane32_swap(__float_as_uint(lg[i]), __float_as_uint(lg[8 + i]), false, false); a8[i] = __uint_as_float(r[0]) + __uint_as_float(r[1]); }
#pragma unroll
    for (int i = 0; i < 4; ++i) { auto r = __builtin_amdgcn_permlane16_swap(__float_as_uint(a8[i]), __float_as_uint(a8[4 + i]), false, false); a4[i] = __uint_as_float(r[0]) + __uint_as_float(r[1]); }
#pragma unroll
    for (int i = 0; i < 4; ++i) a4[i] = row16_sum(a4[i]);
    float mx = fmaxf(fmaxf(a4[0], a4[1]), fmaxf(a4[2], a4[3])); mx = xrow_max(mx);
    float ex[4], sm = 0.f;
#pragma unroll
    for (int i = 0; i < 4; ++i) { ex[i] = expf(a4[i] - mx); sm += ex[i]; }
    sm = xrow_sum(sm);
    if (doit && (lane & 15) == 0) { f32x4 o; o[0] = ex[0] / sm; o[1] = ex[1] / sm; o[2] = ex[2] / sm; o[3] = ex[3] / sm; *(f32x4*)(dst + 4 * (lane >> 4)) = o; }
}

__global__ void __launch_bounds__(512, 2) fwd_kernel(Params p) {
    extern __shared__ __attribute__((aligned(16))) unsigned char lds_raw[];
    LAS unsigned char* lds = (LAS unsigned char*)lds_raw;
    cg::grid_group grid = cg::this_grid();
    const int G = gridDim.x, bid = blockIdx.x;
    const int NGW = G * 8;
    const int wid_k = __builtin_amdgcn_readfirstlane(threadIdx.x >> 6);
#define PHASE_IDS const int tid = opaque_tid(wid_k), lane = tid & 63, wid = __builtin_amdgcn_readfirstlane(tid >> 6), gw = bid * 8 + wid; (void)lane; (void)gw;
    {
        LAS unsigned long long* PT = (LAS unsigned long long*)(lds + PT_OFF);
        if (threadIdx.x == 0) {
            PT[0] = (unsigned long long)p.in[0]; PT[1] = (unsigned long long)p.in[1]; PT[2] = (unsigned long long)p.in[2]; PT[3] = (unsigned long long)p.in[3];
            PT[4] = (unsigned long long)p.in[4]; PT[5] = (unsigned long long)p.in[5]; PT[6] = (unsigned long long)p.in[6]; PT[7] = (unsigned long long)p.in[7];
            PT[8] = (unsigned long long)p.in[8]; PT[9] = (unsigned long long)p.in[9]; PT[10] = (unsigned long long)p.in[10]; PT[11] = (unsigned long long)p.in[11];
            PT[12] = (unsigned long long)p.in[12]; PT[13] = (unsigned long long)p.in[13]; PT[14] = (unsigned long long)p.in[14]; PT[15] = (unsigned long long)p.in[15];
            PT[16] = (unsigned long long)p.in[16]; PT[17] = (unsigned long long)p.in[17]; PT[18] = (unsigned long long)p.in[18]; PT[19] = (unsigned long long)p.in[19];
            PT[20] = (unsigned long long)p.in[20]; PT[21] = (unsigned long long)p.in[21]; PT[22] = (unsigned long long)p.out; PT[23] = (unsigned long long)p.ws;
            ((LAS unsigned*)(lds + PT_OFF + 192))[0] = 0u; ((LAS unsigned*)(lds + PT_OFF + 192))[1] = 0u;
            (void)xb_add((unsigned*)(p.ws + WS_BAR) + XB_XCNT(xb_xcc_id()), 1u);
        }
        __syncthreads();
    }
#define LDP(i) ldptr(lds, (i))
#define GRID_BAR() xcd_barrier((unsigned*)(WSP + WS_BAR), (volatile LAS unsigned*)(lds + PT_OFF + 192))
#define WSP ((unsigned char*)LDP(23))
#define WPR ((bf16_t*)(WSP + WS_WPR))
#define WQKV0 ((bf16_t*)(WSP + WS_WQKV0))
#define WOUT0 ((bf16_t*)(WSP + WS_WOUT0))
#define WIN1 ((bf16_t*)(WSP + WS_WIN1))
#define WOUT1 ((bf16_t*)(WSP + WS_WOUT1))
#define DFTC ((bf16_t*)(WSP + WS_DFTC))
#define MOD ((float*)(WSP + WS_MOD))
#define ROPEC ((float*)(WSP + WS_ROPE))
#define ROPES (ROPEC + 4096 * 32)
#define AFF ((float*)(WSP + WS_AFF))
#define ROWIDX ((int*)(WSP + WS_ROWIDX))
#define GATEV ((float*)(WSP + WS_GATEV))
#define WGU ((bf16_t*)(WSP + WS_WGU))
#define WDN ((bf16_t*)(WSP + WS_WDN))
#define DFT ((bf16_t*)(WSP + WS_DFT))
#define UVB ((bf16_t*)(WSP + WS_UV))
#define CSB ((float*)(WSP + WS_CS))
#define CTX1 ((float*)(WSP + WS_CTX1))
#define ACTV ((bf16_t*)(WSP + WS_ACTV))
#define QKV ((bf16_t*)(WSP + WS_QKV))
#define PRT ((bf16_t*)(WSP + WS_PRT))
#define PRTC ((bf16_t*)(WSP + WS_PRTC))
#define ACT ((bf16_t*)(WSP + WS_ACT))
#define YB ((bf16_t*)(WSP + WS_Y))
#define ACTC ((bf16_t*)(WSP + WS_ACTC))
#define CNTW ((int*)(WSP + WS_CNT))
#define INV ((int*)(WSP + WS_INV))
#define x_in ((const float*)LDP(0))
#define c_in ((const float*)LDP(1))
#define ctx_in ((const float*)LDP(2))
#define cctx_in ((const float*)LDP(3))
#define ada_w ((const float*)LDP(4))
#define ada_b ((const float*)LDP(5))
#define norm1_g ((const float*)LDP(6))
#define norm2_g ((const float*)LDP(7))
#define router_w ((const float*)LDP(8))
#define w_gate ((const float*)LDP(9))
#define w_up ((const float*)LDP(10))
#define w_down ((const float*)LDP(11))
#define ev_w_in ((const float*)LDP(12))
#define ev_w_out ((const float*)LDP(13))
#define ev_qg ((const float*)LDP(14))
#define ev_kg ((const float*)LDP(15))
#define ev_sink ((const float*)LDP(16))
#define od_w_in ((const float*)LDP(17))
#define od_w_out ((const float*)LDP(18))
#define od_qg ((const float*)LDP(19))
#define od_kg ((const float*)LDP(20))
#define od_rpb ((const float*)LDP(21))
#define OUT ((float*)LDP(22))

#ifndef SKIP_P0
    for (int rep_ = 0; rep_ < REP_P0; ++rep_) {
    {
        { PHASE_IDS
        LAS float* scr = (LAS float*)(lds + wid * 16640);
        constexpr int I1 = 16 * 12, I2 = 256, I3 = 16 * 48, I4 = 256, I5 = 2 * 16 * 2 * 256, I6 = 2 * 16 * 256;
        constexpr int NIT = I1 + I2 + I3 + I4 + I5 + I6;
        for (int it = gw; it < NIT; it += NGW) {
            int r = it;
            if (r < I1) { const int kb = r / 12, nb = r % 12, n = nb * 64; transpose_item(ev_w_in, 1280, kb * 64, 512 + n, WQKV0, headslot_row(n), headslot_row(n + 32), scr, lane); continue; } r -= I1;
            if (r < I2) { const int kb = r / 16, nb = r % 16; transpose_item(ev_w_out, 1024, kb * 64, nb * 64, WOUT0, nb * 64, nb * 64 + 32, scr, lane); continue; } r -= I2;
            if (r < I3) { const int kb = r / 48, nb = r % 48, n = nb * 64; transpose_item(od_w_in, 3072, kb * 64, n, WIN1, headslot_row(n), headslot_row(n + 32), scr, lane); continue; } r -= I3;
            if (r < I4) { const int kb = r / 16, nb = r % 16; transpose_item(od_w_out, 1024, kb * 64, nb * 64, WOUT1, nb * 64, nb * 64 + 32, scr, lane); continue; } r -= I4;
            if (r < I5) { const int le = r >> 9, which = (r >> 8) & 1, q = r & 255, kb = q / 16, nb = q % 16, f = nb * 64;
                const float* W = (which ? w_up : w_gate) + (size_t)le * 1024 * 1024;
                const int dA = 256 * (f >> 7) + 128 * which + 32 * ((f >> 5) & 3), dB = 256 * ((f + 32) >> 7) + 128 * which + 32 * (((f + 32) >> 5) & 3);
                transpose_item(W, 1024, kb * 64, f, WGU + (size_t)le * 2048 * 1024, dA, dB, scr, lane); continue; } r -= I5;
            { const int le = r >> 8, q = r & 255, kb = q / 16, nb = q % 16;
                transpose_item(w_down + (size_t)le * 1024 * 1024, 1024, kb * 64, nb * 64, WDN + (size_t)le * 1024 * 1024, nb * 64, nb * 64 + 32, scr, lane); }
        }
        __syncthreads(); }
        { PHASE_IDS
            LAS float* tab = (LAS float*)lds;
            for (int j = tid; j < 4096; j += 512) tab[j] = cospif((float)j * (1.0f / 2048.0f));
            __syncthreads();
            for (int r = bid; r < 4096; r += G) {
                const int k = r & 2047, ph = (r >> 11) * 3072, n0 = tid * 8;
                unsigned w[4];
#pragma unroll
                for (int i = 0; i < 4; ++i) { const float v0 = tab[(k * (n0 + 2 * i) + ph) & 4095] * (1.0f / 64.0f), v1 = tab[(k * (n0 + 2 * i + 1) + ph) & 4095] * (1.0f / 64.0f); w[i] = pk2(v0, v1); }
                *(u32x4*)(DFT + (size_t)r * 4096 + n0) = (u32x4){w[0], w[1], w[2], w[3]};
            }
            for (int k = bid; k < 256; k += G) {
                const int cidx = tid; const int part = cidx >> 8, n = cidx & 255;
                const float v = tab[(((k * n) & 255) * 16 + part * 1024) & 4095] * (1.0f / 16.0f);
                DFTC[k * 512 + cidx] = (bf16_t)(pk2(v, 0.f) & 0xffffu);
            }
            for (int idx = bid * 512 + tid; idx < 4096 * 32; idx += G * 512) {
                const int t = idx >> 5, i = idx & 31; const int f = i & 15;
                const float pos = (float)(i < 16 ? (t >> 6) : (t & 63));
                const float inv_freq = powf(10000.0f, -(float)f / 16.0f);
                const float ang = pos * inv_freq;
                ROPEC[idx] = cosf(ang); ROPES[idx] = sinf(ang);
            }
            __syncthreads();
        }
        { PHASE_IDS
            LAS float* wl = (LAS float*)lds;
            LAS float* tb = wl + 32 * 129;
            for (int it = bid; it < 128; it += G) {
                const int g = it >> 5, k0 = (it & 31) * 32;
                for (int j = tid; j < 128; j += 512) tb[j] = cospif((float)j * (1.0f / 64.0f));
                for (int e = tid; e < 32 * 128; e += 512) { const int kk = e >> 7, cc = e & 127; wl[kk * 129 + cc] = ev_w_in[(size_t)(k0 + kk) * 1280 + g * 128 + cc]; }
                __syncthreads();
                const int kk = tid & 31, og = tid >> 5;
                for (int oo = 0; oo < 16; ++oo) {
                    const int o = og * 16 + oo, part = o >> 7, l = o & 127;
                    float a = 0.f;
                    for (int cc = 0; cc < 128; ++cc) a += wl[kk * 129 + cc] * tb[(l * cc - part * 32) & 127];
                    a *= 0.08838834764831845f;
                    WPR[(size_t)(part * 512 + g * 128 + l) * 1024 + k0 + kk] = (bf16_t)(pk2(a, 0.f) & 0xffffu);
                }
                __syncthreads();
            }
        }
        { PHASE_IDS
            LAS float* sv = (LAS float*)lds;
            LAS float* red = sv + 17 * 1024;
            bool loaded = false;
            for (int it = bid; it < 192; it += G) {
                if (!loaded) {
                    for (int e = tid; e < 17 * 1024; e += 512) { const int s = e >> 10, k = e & 1023; const float v = s < 16 ? c_in[s * 1024 + k] : cctx_in[k]; sv[e] = v / (1.0f + expf(-v)); }
                    loaded = true; __syncthreads();
                }
                const int l = it / 96, j0 = (it % 96) * 64;
                const int col = tid & 63, kg = tid >> 6;
                float acc[17];
#pragma unroll
                for (int s = 0; s < 17; ++s) acc[s] = 0.f;
                const float* wp = ada_w + (size_t)l * 1024 * 6144 + j0 + col;
                for (int k = kg * 128; k < kg * 128 + 128; ++k) { const float w = wp[(size_t)k * 6144];
#pragma unroll
                    for (int s = 0; s < 17; ++s) acc[s] += sv[s * 1024 + k] * w; }
#pragma unroll
                for (int s = 0; s < 17; ++s) red[(kg * 17 + s) * 64 + col] = acc[s];
                __syncthreads();
                for (int e = tid; e < 17 * 64; e += 512) { const int s = e >> 6, cc = e & 63; float a = 0.f;
#pragma unroll
                    for (int q = 0; q < 8; ++q) a += red[(q * 17 + s) * 64 + cc];
                    MOD[(size_t)(l * 17 + s) * 6144 + j0 + cc] = a + ada_b[l * 6144 + j0 + cc]; }
                __syncthreads();
            }
        }
    }
    }
#endif
    grid.sync();

    for (int layer = 0; layer < 2; ++layer) {
        const float* modl = MOD + (size_t)layer * 17 * 6144;
        const float* xin = layer == 0 ? x_in : OUT;
        const float* cin = layer == 0 ? ctx_in : CTX1;
#ifndef SKIP_N1
    if (layer == 0) {
    for (int rep_ = 0; rep_ < REP_N1; ++rep_) {
        { PHASE_IDS
            const float* gn = norm1_g + layer * 1024;
            const float* xin_ = xin; const float* cin_ = cin; const float* modp = modl; bf16_t* actv = ACTV;
            if (gw < 544) {
                const int l = gw / 272, r_ = gw % 272, s_ = r_ >> 4, e_ = r_ & 15;
                const float* shp = MOD + (size_t)(l * 17 + s_) * 6144 + 3 * 1024; const float* rwp = router_w + (size_t)l * 1024 * 16;
                float a_ = 0.f;
#pragma unroll
                for (int i = 0; i < 16; ++i) a_ += shp[lane + 64 * i] * rwp[(lane + 64 * i) * 16 + e_];
                a_ = wave_sum_fast(a_);
                if (lane == 0) CSB[(l * 17 + s_) * 16 + e_] = a_;
            }
            f32x4 vn[4];
            { const float* xr0 = gw < NX ? xin_ + (size_t)gw * D : cin_ + (size_t)(gw - NX) * D;
#pragma unroll
              for (int j = 0; j < 4; ++j) vn[j] = *(const f32x4*)(xr0 + 4 * lane + 256 * j); }
            for (int row = gw; row < NR; row += NGW) {
                const bool isx = row < NX; const int s = isx ? (row >> 12) : 16;
                const float* sh = modp + (size_t)s * 6144; const float* sc = sh + 1024;
                f32x4 v[4]; float ss = 0.f;
#pragma unroll
                for (int j = 0; j < 4; ++j) { v[j] = vn[j]; ss += (v[j][0] * v[j][0] + v[j][1] * v[j][1]) + (v[j][2] * v[j][2] + v[j][3] * v[j][3]); }
                { const int nr = row + NGW; if (nr < NR) { const float* xr1 = nr < NX ? xin_ + (size_t)nr * D : cin_ + (size_t)(nr - NX) * D;
#pragma unroll
                    for (int j = 0; j < 4; ++j) vn[j] = *(const f32x4*)(xr1 + 4 * lane + 256 * j); } }
                const float rstd = 1.0f / sqrtf(wave_sum_fast(ss) * (1.0f / 1024.0f) + 1e-6f);
#pragma unroll
                for (int j = 0; j < 4; ++j) { const int c = 4 * lane + 256 * j; const f32x4 g = *(const f32x4*)(gn + c), a = *(const f32x4*)(sc + c), bsh = *(const f32x4*)(sh + c);
                    const f32x4 h = (v[j] * rstd) * g * (a + 1.0f) + bsh;
                    u32x2 w; w.x = pk2(h[0], h[1]); w.y = pk2(h[2], h[3]); *(u32x2*)(actv + (size_t)row * D + c) = w; }
            }
        }
    }
        GRID_BAR();
    }
#endif
#ifndef SKIP_INP
    for (int rep_ = 0; rep_ < REP_INP; ++rep_) {
        if (layer == 0) {
            { pg8::Gemm g{ACTV, WPR, 1024, nullptr}; pg8::StaticOrder S; S.init(NR, 1024, G, (bid + 64) % G); EpiPR E{PRT, PRTC};
              pg8::gemm_phase<EpiPR, pg8::StaticOrder, true, false>(lds, g, S, E, wid_k); }
            { pg8::Gemm g{ACTV, WQKV0, 1024, nullptr}; pg8::StaticOrder S; S.init(NR, 768, G, bid); EpiQKV<0> E{QKV, ev_qg, ev_kg, ROPEC, ROPES};
              pg8::gemm_phase<EpiQKV<0>, pg8::StaticOrder, false, false>(lds, g, S, E, wid_k); }
        } else {
            EpiQKV<1> E{QKV, od_qg, od_kg, nullptr, nullptr};
            { pg8::Gemm g{ACTV, WIN1, 1024, nullptr}; pg8::StaticOrder S; S.init(NX, 3072, G, bid);
              pg8::gemm_phase<EpiQKV<1>, pg8::StaticOrder, false, false>(lds, g, S, E, wid_k); }
            { pg8::Gemm g{ACTV, WIN1, 1024, nullptr}; pg8::StaticOrder S; S.init(NC, 2048, G, bid, NX / 256, 4);
              pg8::gemm_phase<EpiQKV<1>, pg8::StaticOrder, false, false>(lds, g, S, E, wid_k); }
        }
    }
#endif
        GRID_BAR();
#ifndef SKIP_MIX
    for (int rep_ = 0; rep_ < REP_MIX; ++rep_) {
        if (layer == 0) {
            for (int rf_ = 0; rf_ < REP_FOUR; ++rf_)
            { pg8::Gemm g{DFT, PRT, 4096, nullptr}; FourierSched S; S.so.init(2048, 16384, G, bid); EpiUV E{UVB};
              pg8::gemm_phase<EpiUV, FourierSched, false, false>(lds, g, S, E, wid_k); }
            { pg8::Gemm g{DFTC, PRTC, 512, nullptr}; pg8::StaticOrder S; S.init(256, 8192, G, bid); EpiFourier E{ACTV, NX, LC};
              pg8::gemm_phase<EpiFourier, pg8::StaticOrder, false, false>(lds, g, S, E, wid_k); }
            __syncthreads();
            GRID_BAR();
            { PHASE_IDS
                const bf16_t* uvb = UVB; bf16_t* actv = ACTV; const bf16_t* prt = PRT;
                for (int it = gw; it < 16 * 2048; it += NGW) {
                    const int b = it >> 11, k = it & 2047;
                    const u32x4 uu = *(const u32x4*)(uvb + ((size_t)(b * 2) * 2048 + k) * 512 + 8 * lane), vv = *(const u32x4*)(uvb + ((size_t)(b * 2 + 1) * 2048 + k) * 512 + 8 * lane);
                    u32x4 ym, yp;
#pragma unroll
                    for (int q = 0; q < 4; ++q) { const float u0 = __uint_as_float(uu[q] << 16), u1 = __uint_as_float(uu[q] & 0xffff0000u), v0 = __uint_as_float(vv[q] << 16), v1 = __uint_as_float(vv[q] & 0xffff0000u);
                        ym[q] = pk2(u0 - v0, u1 - v1); yp[q] = pk2(u0 + v0, u1 + v1); }
                    *(u32x4*)(actv + ((size_t)b * SEQ + k) * D + 8 * lane) = ym;
                    if (k > 0) *(u32x4*)(actv + ((size_t)b * SEQ + (SEQ - k)) * D + 8 * lane) = yp;
                }
                for (int it = gw; it < 16 * 512; it += NGW) {
                    const int b = it >> 9, gl = it & 511;
                    const bf16_t* pr = prt + ((size_t)(b * 2) * 512 + gl) * 4096;
                    float acc = 0.f;
#pragma unroll
                    for (int i = 0; i < 8; ++i) { const u32x4 x = *(const u32x4*)(pr + (i * 64 + lane) * 8);
#pragma unroll
                        for (int q = 0; q < 4; ++q) acc += __uint_as_float(x[q] << 16) - __uint_as_float(x[q] & 0xffff0000u); }
                    acc = wave_sum_fast(acc) * (1.0f / 64.0f);
                    if (lane == 0) actv[((size_t)b * SEQ + 2048) * D + gl] = (bf16_t)(pk2(acc, 0.f) & 0xffffu);
                }
            }
            float sb0; { PHASE_IDS sb0 = score_bound(ev_qg, ev_kg, nullptr, 0, ev_sink, 8, lane); }
            for (int u = bid; u < 2048 * REP_SWA; u += G) {
                int uu = u & 2047;
                if (G == 256) { const int k_ = uu >> 8, x_ = bid & 7, m_ = bid >> 3, bk_ = m_ >> 3; uu = ((2 * k_ + (bk_ >> 1)) << 7) | ((bk_ & 1) << 6) | (8 * x_ + (m_ & 7)); }
                attn_unit<0>(uu, QKV, ACTV, ev_sink, nullptr, sb0, lds, wid_k); }
            for (int u = bid; u < 128; u += G) attn_unit<1>(u, QKV, ACTV, ev_sink, nullptr, sb0, lds, wid_k);
        } else {
            float sb1; { PHASE_IDS
                const int h_ = 2 * (bid & 7) + (bid >> 7);
                sb1 = (G == 256) ? score_bound(od_qg, od_kg, od_rpb + h_ * 465, 465, nullptr, 0, lane) : score_bound(od_qg, od_kg, od_rpb, 16 * 465, nullptr, 0, lane); }
            for (int u = bid; u < 4096 * REP_NA; u += G) {
                int uu = u & 4095;
                if (G == 256) { const int k_ = uu >> 8, m_ = bid >> 3; uu = (k_ << 8) | ((2 * (bid & 7) + (m_ >> 4)) << 4) | (m_ & 15); }
                attn_unit<2>(uu, QKV, ACTV, nullptr, od_rpb, sb1, lds, wid_k); }
        }
    }
#endif
        GRID_BAR();
#ifndef SKIP_OUTP
    for (int rep_ = 0; rep_ < REP_OUTP; ++rep_) {
        {
            pg8::Gemm g{ACTV, layer == 0 ? WOUT0 : WOUT1, 1024, nullptr}; pg8::StaticOrder S; S.init(layer == 0 ? NR : NX, 1024, G, bid);
            EpiOut E{xin, OUT, cin, CTX1, modl};
            pg8::gemm_phase<EpiOut, pg8::StaticOrder, false, false>(lds, g, S, E, wid_k);
        }
    }
#endif
        GRID_BAR();
#ifndef SKIP_N2
    for (int rep_ = 0; rep_ < REP_N2; ++rep_) {
#if N2_MFMA == 2
        { PHASE_IDS
            const int nrows = layer == 0 ? NR : NX;
            LAS float* wl = (LAS float*)lds;
            LAS float* ab = wl + 16 * 4 * 16 * 20 + wid * (16 * 68 + 16);
            LAS float* rsd = ab + 16 * 68;
            const float* rw = router_w + (size_t)layer * 1024 * 16;
            for (int e = tid; e < 1024 * 16; e += 512) { const int k = e >> 4, j = e & 15; wl[(((k >> 6) * 4 + ((k >> 4) & 3)) * 16 + j) * 20 + (k & 15)] = rw[e]; }
            __syncthreads();
            const float* gn = norm2_g + layer * 1024;
            const float* outp = OUT; const float* ctx1 = CTX1; bf16_t* actv = ACTV; float* aff = AFF; const float* modp = modl; const float* cs = CSB + layer * 272;
            const int i16 = lane & 15, kq = lane >> 4, c4 = i16 * 4;
            const int ngrp = nrows >> 4;
            for (int grp = gw; grp < ngrp; grp += NGW) {
                const int row0 = grp * 16; const bool isx = row0 < NX; const int s = isx ? (row0 >> 12) : 16;
                const float* xg = isx ? outp + (size_t)row0 * D : ctx1 + (size_t)(row0 - NX) * D;
                const float* shp = modp + (size_t)s * 6144 + 3 * 1024; const float* scp = shp + 1024;
                f32x4 acc = (f32x4){0.f, 0.f, 0.f, 0.f}; float ssq[4] = {0.f, 0.f, 0.f, 0.f};
                f32x4 xa[4], xb[4], xc[4], ga, gb, gc;
#define N2_LOAD(X, G_, c_) do { _Pragma("unroll") for (int q = 0; q < 4; ++q) X[q] = *(const f32x4*)(xg + (size_t)(4 * q + kq) * D + (c_) * 64 + c4); \
                    G_ = *(const f32x4*)(gn + (c_) * 64 + c4) * (*(const f32x4*)(scp + (c_) * 64 + c4) + 1.0f); } while (0)
#define N2_CHUNK(X, G_, c_) do { \
                    _Pragma("unroll") for (int q = 0; q < 4; ++q) { const f32x4 x4 = X[q]; ssq[q] += (x4[0] * x4[0] + x4[1] * x4[1]) + (x4[2] * x4[2] + x4[3] * x4[3]); *(LAS f32x4*)(ab + (4 * q + kq) * 68 + c4) = x4 * G_; } \
                    if ((c_) + 3 < 16) N2_LOAD(X, G_, (c_) + 3); \
                    const LAS float* ap = ab + i16 * 68 + kq * 16; const LAS float* bp = wl + (((c_) * 4 + kq) * 16 + i16) * 20; \
                    _Pragma("unroll") for (int m = 0; m < 4; ++m) { const f32x4 a4 = *(const LAS f32x4*)(ap + 4 * m), b4 = *(const LAS f32x4*)(bp + 4 * m); \
                        acc = __builtin_amdgcn_mfma_f32_16x16x4f32(a4[0], b4[0], acc, 0, 0, 0); acc = __builtin_amdgcn_mfma_f32_16x16x4f32(a4[1], b4[1], acc, 0, 0, 0); \
                        acc = __builtin_amdgcn_mfma_f32_16x16x4f32(a4[2], b4[2], acc, 0, 0, 0); acc = __builtin_amdgcn_mfma_f32_16x16x4f32(a4[3], b4[3], acc, 0, 0, 0); } \
                    asm volatile("s_waitcnt lgkmcnt(0)" ::: "memory"); } while (0)
                N2_LOAD(xa, ga, 0); N2_LOAD(xb, gb, 1); N2_LOAD(xc, gc, 2);
                for (int c = 0; c < 15; c += 3) { N2_CHUNK(xa, ga, c); N2_CHUNK(xb, gb, c + 1); N2_CHUNK(xc, gc, c + 2); }
                N2_CHUNK(xa, ga, 15);
#undef N2_LOAD
#undef N2_CHUNK
#pragma unroll
                for (int q = 0; q < 4; ++q) { const float t_ = row16_sum(ssq[q]); if (i16 == 0) rsd[4 * q + kq] = 1.0f / sqrtf(t_ * (1.0f / 1024.0f) + 1e-6f); }
                asm volatile("s_waitcnt lgkmcnt(0)" ::: "memory");
                const float cse = cs[s * 16 + i16];
#pragma unroll
                for (int r = 0; r < 4; ++r) {
                    const float lgt = rsd[4 * kq + r] * acc[r] + cse;
                    const float mx = row16_max(lgt), ex = expf(lgt - mx), sm = row16_sum(ex);
                    aff[(size_t)(row0 + 4 * kq + r) * 16 + i16] = ex / sm;
                }
                float rs4[4];
#pragma unroll
                for (int q = 0; q < 4; ++q) rs4[q] = rsd[4 * q + kq];
#pragma unroll 4
                for (int c = 0; c < 16; ++c) {
                    const int col = c * 64 + c4; const f32x4 g4 = *(const f32x4*)(gn + col), a4 = *(const f32x4*)(scp + col) + 1.0f, b4 = *(const f32x4*)(shp + col);
#pragma unroll
                    for (int q = 0; q < 4; ++q) { const f32x4 x4 = *(const f32x4*)(xg + (size_t)(4 * q + kq) * D + col);
                        const f32x4 h = (x4 * rs4[q]) * g4 * a4 + b4; u32x2 w; w.x = pk2(h[0], h[1]); w.y = pk2(h[2], h[3]); *(u32x2*)(actv + (size_t)(row0 + 4 * q + kq) * D + col) = w; }
                }
                asm volatile("s_waitcnt lgkmcnt(0)" ::: "memory");
            }
        }
#elif N2_MFMA
        { PHASE_IDS
            const int nrows = layer == 0 ? NR : NX;
            LAS float* wl = (LAS float*)lds;
            const float* rw = router_w + (size_t)layer * 1024 * 16;
            for (int e = tid; e < 1024 * 16; e += 512) { const int k = e >> 4, j = e & 15; wl[((k >> 8) * 16 + j) * 260 + (k & 255)] = rw[e]; }
            __syncthreads();
            const float* gn = norm2_g + layer * 1024;
            const float* outp = OUT; const float* ctx1 = CTX1; bf16_t* actv = ACTV; float* aff = AFF; const float* modp = modl; const float* cs = CSB + layer * 272;
            const int i16 = lane & 15, kq = lane >> 4;
            const LAS float* wb = wl + (kq * 16 + i16) * 260;
            const int ngrp = nrows >> 4;
            for (int grp = gw; grp < ngrp; grp += NGW) {
                const int row0 = grp * 16; const bool isx = row0 < NX; const int s = isx ? (row0 >> 12) : 16;
                const float* xr = (isx ? outp + (size_t)row0 * D : ctx1 + (size_t)(row0 - NX) * D) + (size_t)i16 * D + kq * 256;
                const float* shp = modp + (size_t)s * 6144 + 3 * 1024 + kq * 256; const float* scp = shp + 1024; const float* gp = gn + kq * 256;
                f32x4 acc = (f32x4){0.f, 0.f, 0.f, 0.f}; float ss = 0.f;
#pragma unroll 4
                for (int c = 0; c < 64; ++c) {
                    const f32x4 x4 = *(const f32x4*)(xr + 4 * c), g4 = *(const f32x4*)(gp + 4 * c), a4 = *(const f32x4*)(scp + 4 * c);
                    const f32x4 w4 = *(const LAS f32x4*)(wb + 4 * c);
                    ss += (x4[0] * x4[0] + x4[1] * x4[1]) + (x4[2] * x4[2] + x4[3] * x4[3]);
                    const f32x4 u4 = (x4 * g4) * (a4 + 1.0f);
                    acc = __builtin_amdgcn_mfma_f32_16x16x4f32(u4[0], w4[0], acc, 0, 0, 0);
                    acc = __builtin_amdgcn_mfma_f32_16x16x4f32(u4[1], w4[1], acc, 0, 0, 0);
                    acc = __builtin_amdgcn_mfma_f32_16x16x4f32(u4[2], w4[2], acc, 0, 0, 0);
                    acc = __builtin_amdgcn_mfma_f32_16x16x4f32(u4[3], w4[3], acc, 0, 0, 0);
                }
                ss = xrow_sum(ss);
                const float rstd = 1.0f / sqrtf(ss * (1.0f / 1024.0f) + 1e-6f);
                const float cse = cs[s * 16 + i16];
#pragma unroll
                for (int r = 0; r < 4; ++r) {
                    const float rr = __int_as_float(__builtin_amdgcn_ds_bpermute((4 * kq + r) << 2, __float_as_int(rstd)));
                    const float lgt = rr * acc[r] + cse;
                    const float mx = row16_max(lgt), ex = expf(lgt - mx), sm = row16_sum(ex);
                    aff[(size_t)(row0 + 4 * kq + r) * 16 + i16] = ex / sm;
                }
                bf16_t* hp = actv + (size_t)(row0 + i16) * D + kq * 256;
#pragma unroll 2
                for (int c = 0; c < 32; ++c) {
                    unsigned w[4];
#pragma unroll
                    for (int q = 0; q < 2; ++q) { const int o = 8 * c + 4 * q; const f32x4 x4 = *(const f32x4*)(xr + o), g4 = *(const f32x4*)(gp + o), a4 = *(const f32x4*)(scp + o), b4 = *(const f32x4*)(shp + o);
                        const f32x4 h = (x4 * rstd) * g4 * (a4 + 1.0f) + b4; w[2 * q] = pk2(h[0], h[1]); w[2 * q + 1] = pk2(h[2], h[3]); }
                    *(u32x4*)(hp + 8 * c) = (u32x4){w[0], w[1], w[2], w[3]};
                }
            }
        }
#else
        { PHASE_IDS
            const int nrows = layer == 0 ? NR : NX;
            LAS f32x4* wl = (LAS f32x4*)lds;
            const float* rw = router_w + (size_t)layer * 1024 * 16;
            for (int e = tid; e < 1024 * 4; e += 512) { const int col = e >> 2, e4 = e & 3; const int c = col & 3, ln = (col >> 2) & 63, j = col >> 8;
                wl[((c * 4 + j) * 4 + e4) * 64 + ln] = *(const f32x4*)(rw + col * 16 + e4 * 4); }
            __syncthreads();
            const float* gn = norm2_g + layer * 1024;
            const float* outp = OUT; const float* ctx1 = CTX1; bf16_t* actv = ACTV; float* aff = AFF; const float* modp = modl;
            f32x4 vn[4];
#pragma unroll
            for (int j = 0; j < 4; ++j) vn[j] = (f32x4){0.f, 0.f, 0.f, 0.f};
            for (int row = gw; row < nrows; row += NGW) {
                const bool isx = row < NX; const int s = isx ? (row >> 12) : 16;
                if (row == gw) { const float* xr0 = isx ? outp + (size_t)row * D : ctx1 + (size_t)(row - NX) * D;
#pragma unroll
                    for (int j = 0; j < 4; ++j) vn[j] = *(const f32x4*)(xr0 + 4 * lane + 256 * j); }
                const float* sh = modp + (size_t)s * 6144 + 3 * 1024; const float* sc = sh + 1024;
                f32x4 v[4]; float ss = 0.f;
#pragma unroll
                for (int j = 0; j < 4; ++j) { v[j] = vn[j]; ss += (v[j][0] * v[j][0] + v[j][1] * v[j][1]) + (v[j][2] * v[j][2] + v[j][3] * v[j][3]); }
                const float rstd = 1.0f / sqrtf(wave_sum_fast(ss) * (1.0f / 1024.0f) + 1e-6f);
                f32x2_t lg2[8];
#pragma unroll
                for (int e = 0; e < 8; ++e) lg2[e] = (f32x2_t){0.f, 0.f};
#pragma unroll
                for (int j = 0; j < 4; ++j) { const int c = 4 * lane + 256 * j; const f32x4 g = *(const f32x4*)(gn + c), a = *(const f32x4*)(sc + c), bsh = *(const f32x4*)(sh + c);
                    const f32x4 h = (v[j] * rstd) * g * (a + 1.0f) + bsh;
                    u32x2 w; w.x = pk2(h[0], h[1]); w.y = pk2(h[2], h[3]); *(u32x2*)(actv + (size_t)row * D + c) = w;
#pragma unroll
                    for (int cc = 0; cc < 4; ++cc) { const f32x2_t hh = (f32x2_t){h[cc], h[cc]};
#pragma unroll
                        for (int e4 = 0; e4 < 4; ++e4) { const f32x4 w4 = wl[((cc * 4 + j) * 4 + e4) * 64 + lane];
                            lg2[e4 * 2 + 0] = __builtin_elementwise_fma(hh, (f32x2_t){w4[0], w4[1]}, lg2[e4 * 2 + 0]); lg2[e4 * 2 + 1] = __builtin_elementwise_fma(hh, (f32x2_t){w4[2], w4[3]}, lg2[e4 * 2 + 1]);
                            if (e4 == 3 && (cc & 1)) asm volatile("" ::: "memory"); } }
                    if (j == 1) { const int nr = row + NGW; if (nr < nrows) { const float* xr1 = nr < NX ? outp + (size_t)nr * D : ctx1 + (size_t)(nr - NX) * D;
#pragma unroll
                        for (int q = 0; q < 4; ++q) vn[q] = *(const f32x4*)(xr1 + 4 * lane + 256 * q); } }
                }
                float lg[16];
#pragma unroll
                for (int e = 0; e < 8; ++e) { lg[2 * e] = lg2[e][0]; lg[2 * e + 1] = lg2[e][1]; }
                router_softmax_store(lg, lane, aff + (size_t)row * 16, true);
            }
        }
#endif
    }
#endif
        GRID_BAR();
#ifndef SKIP_TOPK
    for (int rep_ = 0; rep_ < REP_TOPK; ++rep_) {
        { PHASE_IDS
            LAS int* cnt = (LAS int*)lds;
            LAS int* wsum = cnt + 64;
            const int nprob = layer == 0 ? 512 : 256;
            for (int pr = bid; pr < nprob; pr += G) {
                const bool isx = pr < 256; const int q = pr & 255; const int b = (G == 256) ? 2 * (q & 7) + (q >> 7) : (q >> 4), e = (G == 256) ? ((q >> 3) & 15) : (q & 15);
                const int n = isx ? SEQ : LC, kk = isx ? CAPX : CAPC;
                const int rowbase = isx ? b * SEQ : NX + b * LC;
                const int slotbase = isx ? (e * 16 + b) * CAPX : NSLOT_X + (e * 16 + b) * CAPC;
                if (tid < 40) cnt[tid] = 0;
                unsigned key[8]; bool valid[8];
#pragma unroll
                for (int i = 0; i < 8; ++i) { const int t = tid * 8 + i; valid[i] = t < n; key[i] = valid[i] ? __float_as_uint(AFF[(size_t)(rowbase + t) * 16 + e]) : 0u; }
                __syncthreads();
                unsigned T = 0u;
                for (int bit = 30; bit >= 0; --bit) {
                    const unsigned cand = T | (1u << bit);
                    int c = 0;
#pragma unroll
                    for (int i = 0; i < 8; ++i) c += __builtin_popcountll(__ballot(valid[i] && key[i] >= cand));
                    if (lane == 0 && c) __hip_atomic_fetch_add(&cnt[bit], c, __ATOMIC_RELAXED, __HIP_MEMORY_SCOPE_WORKGROUP);
                    __syncthreads();
                    if (cnt[bit] >= kk) T = cand;
                }
                int ngt = 0, neq = 0;
#pragma unroll
                for (int i = 0; i < 8; ++i) { ngt += (valid[i] && key[i] > T) ? 1 : 0; neq += (valid[i] && key[i] == T) ? 1 : 0; }
                int tot_gt, tot_eq;
                (void)block_excl_scan(ngt, wsum, lane, wid, tot_gt);
                const int eqpre = block_excl_scan(neq, wsum, lane, wid, tot_eq);
                const int need = kk - tot_gt;
                bool take[8]; int ntake = 0, er = eqpre;
#pragma unroll
                for (int i = 0; i < 8; ++i) { const bool gt = valid[i] && key[i] > T, eq = valid[i] && key[i] == T; take[i] = gt || (eq && er < need); er += eq ? 1 : 0; ntake += take[i] ? 1 : 0; }
                int tot_take;
                int pos = block_excl_scan(ntake, wsum, lane, wid, tot_take);
#pragma unroll
                for (int i = 0; i < 8; ++i) { if (valid[i]) INV[(size_t)(rowbase + tid * 8 + i) * 16 + e] = take[i] ? slotbase + pos : -1;
                    if (take[i]) { ROWIDX[slotbase + pos] = rowbase + tid * 8 + i; GATEV[slotbase + pos] = __uint_as_float(key[i]); ++pos; } }
                __syncthreads();
            }
        }
    }
#endif
        GRID_BAR();
#ifndef SKIP_MOE
    for (int rep_ = 0; rep_ < REP_MOE; ++rep_) {
        {
            bf16_t* actp = ACT + (size_t)bid * 256 * 1024;
            const int nx = (512 - bid + G - 1) / G;
            const int ncg = layer == 0 ? (256 - bid + G - 1) / G : 0;
            const int ncd = layer == 0 && bid < 128 ? (128 - bid + G - 1) / G : 0;
            for (int it = 0; it < ncg + nx + ncd; ++it) {
                const bool isgu = it < ncg, isdn = it >= ncg + nx, isx = !isgu && !isdn;
                int e, c = 0, pn0 = 0; const int* gather; bf16_t* abuf; int slot0, ngu = 8, ndn = 4;
                if (isx) { const int kx = it - ncg; const int tile = (G == 256) ? (((bid & 7) + 8 * kx) * 32 + (bid >> 3)) : (bid + kx * G); e = tile >> 5;
                    gather = ROWIDX + tile * 256; abuf = actp; slot0 = tile * 256; }
                else { const int u = bid + (isgu ? it : it - ncg - nx) * G; c = isgu ? (u >> 3) : (u >> 2); pn0 = isgu ? (u & 7) : (u & 3); e = c >> 1;
                    gather = ROWIDX + (512 + c) * 256; abuf = ACTC + (size_t)c * 256 * 1024; slot0 = (512 + c) * 256; ngu = 1; ndn = 1; }
                const int le = layer * 16 + e;
                if (!isdn) {
                    pg8::Gemm g{ACTV, WGU + (size_t)le * 2048 * 1024, 1024, gather}; pg8::TileSched S{0, pn0, ngu}; EpiGU E{abuf};
                    pg8::gemm_phase<EpiGU, pg8::TileSched, false, true>(lds, g, S, E, wid_k);
                    asm volatile("s_waitcnt vmcnt(0)" ::: "memory");
                    __syncthreads();
                    if (isgu) { if (threadIdx.x == 0) { __builtin_amdgcn_fence(__ATOMIC_RELEASE, "agent"); asm volatile("s_waitcnt vmcnt(0)" ::: "memory");
                                    __hip_atomic_fetch_add(CNTW + c, 1, __ATOMIC_RELAXED, __HIP_MEMORY_SCOPE_AGENT); } }
                }
                if (!isgu) {
                    if (isdn) { if (threadIdx.x == 0) { int* cw = CNTW + c; while (__hip_atomic_load(cw, __ATOMIC_RELAXED, __HIP_MEMORY_SCOPE_AGENT) < 8) __builtin_amdgcn_s_sleep(8); }
                                __syncthreads(); }
                    __builtin_amdgcn_fence(__ATOMIC_ACQUIRE, "agent");
                    pg8::Gemm g{abuf, WDN + (size_t)le * 1024 * 1024, 1024, nullptr}; pg8::TileSched S{0, pn0, ndn}; EpiDown E{YB, slot0};
                    pg8::gemm_phase<EpiDown, pg8::TileSched, false, false>(lds, g, S, E, wid_k);
                    __syncthreads();
                }
            }
        }
    }
#endif
        GRID_BAR();
        { PHASE_IDS
            const int nrows = layer == 0 ? NR : NX;
            const int* inv = INV; const float* gatev = GATEV; const bf16_t* yb = YB; float* outp = OUT; float* ctx1 = CTX1;
            const float* gn1 = norm1_g + 1024; const float* modn = MOD + (size_t)17 * 6144; bf16_t* actv = ACTV; const float* modp2 = modl;
            int inv_n = (lane < 16 && gw < nrows) ? inv[(size_t)gw * 16 + lane] : -1;
            for (int row = gw; row < nrows; row += NGW) {
                const bool isx = row < NX; const int s = isx ? (row >> 12) : 16;
                const int myinv = inv_n;
                { const int nr = row + NGW; inv_n = (lane < 16 && nr < nrows) ? inv[(size_t)nr * 16 + lane] : -1; }
                float* xr = isx ? outp + (size_t)row * D : ctx1 + (size_t)(row - NX) * D;
                f32x4 xv4[4];
#pragma unroll
                for (int hh = 0; hh < 2; ++hh)
#pragma unroll
                    for (int q = 0; q < 2; ++q) xv4[hh * 2 + q] = *(const f32x4*)(xr + hh * 512 + 8 * lane + 4 * q);
                float acc[16];
#pragma unroll
                for (int i = 0; i < 16; ++i) acc[i] = 0.f;
                unsigned emask = (unsigned)(__ballot(myinv >= 0) & 0xffffull);
                while (emask) {
                    const int e0 = __builtin_ctz(emask); emask &= emask - 1u;
                    const bool two = emask != 0u; const int e1 = two ? __builtin_ctz(emask) : e0; if (two) emask &= emask - 1u;
                    const int s0 = __builtin_amdgcn_readlane(myinv, e0), s1 = __builtin_amdgcn_readlane(myinv, e1);
                    const float g0 = gatev[s0], g1r = gatev[s1];
                    const u32x4 y0 = *(const u32x4*)(yb + (size_t)s0 * D + 8 * lane), y1 = *(const u32x4*)(yb + (size_t)s0 * D + 512 + 8 * lane);
                    const u32x4 z0 = *(const u32x4*)(yb + (size_t)s1 * D + 8 * lane), z1 = *(const u32x4*)(yb + (size_t)s1 * D + 512 + 8 * lane);
                    const float g1 = two ? g1r : 0.f;
#pragma unroll
                    for (int q = 0; q < 4; ++q) { acc[2 * q] += g0 * __uint_as_float(y0[q] << 16); acc[2 * q + 1] += g0 * __uint_as_float(y0[q] & 0xffff0000u);
                        acc[8 + 2 * q] += g0 * __uint_as_float(y1[q] << 16); acc[8 + 2 * q + 1] += g0 * __uint_as_float(y1[q] & 0xffff0000u); }
#pragma unroll
                    for (int q = 0; q < 4; ++q) { acc[2 * q] += g1 * __uint_as_float(z0[q] << 16); acc[2 * q + 1] += g1 * __uint_as_float(z0[q] & 0xffff0000u);
                        acc[8 + 2 * q] += g1 * __uint_as_float(z1[q] << 16); acc[8 + 2 * q + 1] += g1 * __uint_as_float(z1[q] & 0xffff0000u); }
                }
                const float* g2 = modp2 + (size_t)s * 6144 + 5 * 1024;
#pragma unroll
                for (int hh = 0; hh < 2; ++hh)
#pragma unroll
                    for (int q = 0; q < 2; ++q) { const int c = hh * 512 + 8 * lane + 4 * q; const f32x4 xv = xv4[hh * 2 + q], gv = *(const f32x4*)(g2 + c);
                        f32x4 a; a[0] = acc[hh * 8 + 4 * q]; a[1] = acc[hh * 8 + 4 * q + 1]; a[2] = acc[hh * 8 + 4 * q + 2]; a[3] = acc[hh * 8 + 4 * q + 3];
                        const f32x4 nx_ = xv + gv * a; *(f32x4*)(xr + c) = nx_;
                        acc[hh * 8 + 4 * q] = nx_[0]; acc[hh * 8 + 4 * q + 1] = nx_[1]; acc[hh * 8 + 4 * q + 2] = nx_[2]; acc[hh * 8 + 4 * q + 3] = nx_[3]; }
                if (layer == 0) {
                    float ss = 0.f;
#pragma unroll
                    for (int i = 0; i < 16; ++i) ss += acc[i] * acc[i];
                    const float rstd = 1.0f / sqrtf(wave_sum_fast(ss) * (1.0f / 1024.0f) + 1e-6f);
                    const float* sh1 = modn + (size_t)s * 6144; const float* sc1 = sh1 + 1024;
#pragma unroll
                    for (int hh = 0; hh < 2; ++hh) { const int c = hh * 512 + 8 * lane; unsigned w[4];
#pragma unroll
                        for (int q = 0; q < 2; ++q) { const f32x4 g = *(const f32x4*)(gn1 + c + 4 * q), a = *(const f32x4*)(sc1 + c + 4 * q), bsh = *(const f32x4*)(sh1 + c + 4 * q);
                            f32x4 xv; xv[0] = acc[hh * 8 + 4 * q]; xv[1] = acc[hh * 8 + 4 * q + 1]; xv[2] = acc[hh * 8 + 4 * q + 2]; xv[3] = acc[hh * 8 + 4 * q + 3];
                            const f32x4 h = (xv * rstd) * g * (a + 1.0f) + bsh; w[2 * q] = pk2(h[0], h[1]); w[2 * q + 1] = pk2(h[2], h[3]); }
                        *(u32x4*)(actv + (size_t)row * D + c) = (u32x4){w[0], w[1], w[2], w[3]}; }
                }
            }
        }
        GRID_BAR();
    }
    for (int i = 0; i < EXTRA_SYNCS; ++i) GRID_BAR();
}

extern "C" void kernel_launch(void* const* d_in, const int* in_sizes, int n_in, void* d_out, int out_size, void* d_ws, size_t ws_size, hipStream_t stream) {
    static int grid = 0;
    if (grid == 0) {
        if (n_in != 22 || out_size != NX * D || ws_size < WS_END) { fprintf(stderr, "kernel_launch: unexpected shapes (n_in %d out %d ws %zu need %zu)\n", n_in, out_size, ws_size, (size_t)WS_END); grid = -1; return; }
        int dev = 0, cus = 0, per_cu = 0;
        (void)hipGetDevice(&dev);
        (void)hipDeviceGetAttribute(&cus, hipDeviceAttributeMultiprocessorCount, dev);
        if (hipFuncSetAttribute((const void*)fwd_kernel, hipFuncAttributeMaxDynamicSharedMemorySize, LDS_BYTES) != hipSuccess) { fprintf(stderr, "kernel_launch: hipFuncSetAttribute failed\n"); grid = -1; return; }
        (void)hipOccupancyMaxActiveBlocksPerMultiprocessor(&per_cu, (const void*)fwd_kernel, 512, LDS_BYTES);
        if (per_cu < 1) { fprintf(stderr, "kernel_launch: occupancy query says %d blocks per CU\n", per_cu); per_cu = 1; }
        (void)hipGetLastError();
        grid = cus * per_cu; if (grid > 256) grid = 256;
    }
    if (grid < 0) return;
    if (hipMemsetAsync((char*)d_ws + WS_CNT, 0, 64 * 1024, stream) != hipSuccess) { fprintf(stderr, "kernel_launch: memset of control words failed\n"); return; }
    Params p{};
    for (int i = 0; i < 22; ++i) p.in[i] = (const float*)d_in[i];
    p.out = (float*)d_out; p.ws = (unsigned char*)d_ws;
    void* args[] = {&p};
    hipError_t e = hipLaunchCooperativeKernel((const void*)fwd_kernel, dim3(grid), dim3(512), args, LDS_BYTES, stream);
    if (e != hipSuccess) fprintf(stderr, "cooperative launch failed: %s (grid %d)\n", hipGetErrorString(e), grid);
}
```

```cpp
#include <hip/hip_runtime.h>
#include <hip/hip_cooperative_groups.h>
#include <cstdio>
#include <cstdint>
namespace cg = cooperative_groups;

#define DI __device__ __forceinline__
#define LAS __attribute__((address_space(3)))
typedef unsigned short bf16_t;
typedef short bf16x8 __attribute__((ext_vector_type(8)));
typedef short s16x4 __attribute__((ext_vector_type(4)));
typedef float f32x4 __attribute__((ext_vector_type(4)));
typedef float f32x16 __attribute__((ext_vector_type(16)));
typedef unsigned u32x4 __attribute__((ext_vector_type(4)));
typedef unsigned u32x2 __attribute__((ext_vector_type(2)));
typedef float f32x2_t __attribute__((ext_vector_type(2)));
typedef __bf16 bf16x2_t __attribute__((ext_vector_type(2)));

DI int opaque_tid(int wid_s) { int l; asm volatile("v_mbcnt_lo_u32_b32 %0, -1, 0\n\tv_mbcnt_hi_u32_b32 %0, -1, %0" : "=v"(l)); asm volatile("" : "+s"(wid_s)); return (wid_s << 6) | l; }
DI unsigned pk2(float lo, float hi) { f32x2_t v = {lo, hi}; bf16x2_t b = __builtin_convertvector(v, bf16x2_t); return __builtin_bit_cast(unsigned, b); }
DI float shx(float v, int m, int lane) { return __int_as_float(__builtin_amdgcn_ds_bpermute((lane ^ m) << 2, __float_as_int(v))); }
DI float wave_sum(float v, int lane) {
#pragma unroll
    for (int o = 1; o < 64; o <<= 1) v += shx(v, o, lane);
    return v;
}

template <int CTRL> DI float dppf(float v) { return __int_as_float(__builtin_amdgcn_update_dpp(0, __float_as_int(v), CTRL, 0xF, 0xF, true)); }
DI float row16_sum(float v) { v += dppf<0xB1>(v); v += dppf<0x4E>(v); v += dppf<0x124>(v); v += dppf<0x128>(v); return v; }
DI float xrow_sum(float v) { auto r = __builtin_amdgcn_permlane16_swap(__float_as_uint(v), __float_as_uint(v), false, false); v = __uint_as_float(r[0]) + __uint_as_float(r[1]);
    auto q = __builtin_amdgcn_permlane32_swap(__float_as_uint(v), __float_as_uint(v), false, false); return __uint_as_float(q[0]) + __uint_as_float(q[1]); }
DI float xrow_max(float v) { auto r = __builtin_amdgcn_permlane16_swap(__float_as_uint(v), __float_as_uint(v), false, false); v = fmaxf(__uint_as_float(r[0]), __uint_as_float(r[1]));
    auto q = __builtin_amdgcn_permlane32_swap(__float_as_uint(v), __float_as_uint(v), false, false); return fmaxf(__uint_as_float(q[0]), __uint_as_float(q[1])); }
DI float wave_sum_fast(float v) { return xrow_sum(row16_sum(v)); }
DI float row16_max(float v) { v = fmaxf(v, dppf<0xB1>(v)); v = fmaxf(v, dppf<0x4E>(v)); v = fmaxf(v, dppf<0x124>(v)); v = fmaxf(v, dppf<0x128>(v)); return v; }
#ifndef REP_P0
#define REP_P0 1
#endif
#ifndef REP_N1
#define REP_N1 1
#endif
#ifndef REP_INP
#define REP_INP 1
#endif
#ifndef REP_MIX
#define REP_MIX 1
#endif
#ifndef REP_OUTP
#define REP_OUTP 1
#endif
#ifndef REP_N2
#define REP_N2 1
#endif
#ifndef REP_TOPK
#define REP_TOPK 1
#endif
#ifndef REP_MOE
#define REP_MOE 1
#endif
#ifndef REP_FOUR
#define REP_FOUR 1
#endif
#ifndef REP_SWA
#define REP_SWA 1
#endif
#ifndef REP_NA
#define REP_NA 1
#endif
#ifndef EXTRA_SYNCS
#define EXTRA_SYNCS 0
#endif
#ifndef PG8_ALIGN_EPI
#define PG8_ALIGN_EPI 1
#endif
#ifndef REP_EPI
#define REP_EPI 1
#endif
#ifndef N2_MFMA
#define N2_MFMA 2
#endif
constexpr int D = 1024, NB = 16, SEQ = 4096, LC = 256;
constexpr int NX = NB * SEQ, NC = NB * LC, NR = NX + NC;
constexpr int NE = 16, CAPX = 512, CAPC = 32;
constexpr int NSLOT_X = NB * NE * CAPX, NSLOT_C = NB * NE * CAPC, NSLOT = NSLOT_X + NSLOT_C;
constexpr float LOG2E = 1.4426950408889634f;
constexpr float QSCALE = 0.125f * LOG2E;

constexpr size_t MiB = 1u << 20;
constexpr size_t WS_WPR = 0, WS_WQKV0 = 2 * MiB, WS_WOUT0 = 4 * MiB, WS_WIN1 = 6 * MiB, WS_WOUT1 = 12 * MiB, WS_DFTC = 14 * MiB;
constexpr size_t WS_MOD = 15 * MiB, WS_ROPE = 16 * MiB, WS_AFF = 17 * MiB, WS_ROWIDX = 22 * MiB, WS_GATEV = 23 * MiB;
constexpr size_t WS_WGU = 24 * MiB, WS_WDN = 152 * MiB, WS_DFT = 216 * MiB, WS_CTX1 = 280 * MiB, WS_ACTV = 296 * MiB, WS_BIG = 432 * MiB;
constexpr size_t WS_QKV = WS_BIG, WS_PRT = WS_BIG + 104 * MiB, WS_PRTC = WS_BIG + 232 * MiB, WS_ACT = WS_BIG  , WS_Y = WS_BIG + 128 * MiB  , WS_INV = WS_BIG + 400 * MiB  ;
constexpr size_t WS_ACTC = WS_DFT  , WS_CNT = WS_GATEV + 768 * 1024  ;
constexpr size_t WS_CS = WS_MOD + 900 * 1024  ;
constexpr size_t WS_UV = WS_BIG + 240 * MiB  ;
constexpr size_t WS_BAR = WS_GATEV + 800 * 1024  ;
constexpr size_t WS_END = WS_BIG + 408 * MiB;

constexpr int LDS_BYTES = 147456, PT_OFF = LDS_BYTES - 256;
DI void* ldptr(LAS unsigned char* lds, int i) { int a_ = PT_OFF + 8 * i; asm volatile("" : "+v"(a_)); const unsigned long long v = *(LAS unsigned long long*)(lds + a_);
    const unsigned lo = __builtin_amdgcn_readfirstlane((unsigned)v), hi = __builtin_amdgcn_readfirstlane((unsigned)(v >> 32));
    return (void*)(__attribute__((address_space(1))) void*)(((unsigned long long)hi << 32) | lo); }

struct Params { const float* in[22]; float* out; unsigned char* ws; };

namespace pg8 {
constexpr int BM = 256, BK = 64, HALF = 128, HTB = HALF * BK * 2, STAGE_BYTES = 8 * HTB, NXCD = 8, WGM = 4;
DI int lds_byte(int r, int c) { const int st = (r >> 4) * 2 + (c >> 5), rr = r & 15, cc = c & 31, ob = rr * 64 + cc * 2; return st * 1024 + (ob ^ (((ob >> 9) & 1) << 5)); }
DI void stage_rc(int b, int& R, int& C) { const int st = b / 1024, sb = b % 1024, swz = sb ^ (((sb >> 9) & 1) << 5); R = (st >> 1) * 16 + swz / 64; C = (st & 1) * 32 + (swz % 64) / 2; }

DI int perm32(int rho) { const int n = rho >> 4, i = rho & 15; return 8 * (i >> 2) + 4 * n + (i & 3); }
struct Unit { int pm, pn; };
struct Gemm { const bf16_t* A; const bf16_t* Bt; int K; const int* gather; };

struct StaticOrder {
    int nM, nN, nwg, G, c, pm_off, pn_off;
    DI void init(int M, int N, int G_, int c_, int pmo = 0, int pno = 0) { nM = M / BM; nN = N / BM; nwg = nM * nN; G = G_; c = c_; pm_off = pmo; pn_off = pno; }
    DI bool next(int i, Unit& u) const {
        const long L = (long)i * G + c; if (L >= nwg) return false;
        int wgid = (int)L; { const int q = nwg / NXCD, r = nwg % NXCD, xcd = wgid % NXCD, off = wgid / NXCD; wgid = (xcd < r ? xcd * (q + 1) : r * (q + 1) + (xcd - r) * q) + off; }
        const int nig = WGM * nN, gid = wgid / nig, fm = gid * WGM, gsz = (nM - fm) < WGM ? (nM - fm) : WGM;
        u.pm = pm_off + fm + ((wgid % nig) % gsz); u.pn = pn_off + (wgid % nig) / gsz; return true;
    }
};
struct TileSched {
    int pm, pn0, nU;
    DI bool next(int i, Unit& u) const { if (i >= nU) return false; u.pm = pm; u.pn = pn0 + i; return true; }
};

template <class Epi, class Sched, bool SWAP, bool GATHER>
DI void gemm_phase(LAS unsigned char* lds, const Gemm g, const Sched& S, const Epi& E, int wid_s) {
    const int tid = opaque_tid(wid_s), wid = __builtin_amdgcn_readfirstlane(tid >> 6), lane = tid & 63, wr = wid >> 2, wc = wid & 3, fr = lane & 15, fq = lane >> 4;
    const int K = g.K, nt = K / BK;
    unsigned voffA0[2], voffA1[2], voffB[2];
#pragma unroll
    for (int i = 0; i < 2; ++i) { int R, C; stage_rc(tid * 16 + i * 8192, R, C);
        if constexpr (GATHER) { voffA0[i] = (unsigned)(g.gather[R] * K + C) * 2u; voffA1[i] = (unsigned)(g.gather[HALF + R] * K + C) * 2u; }
        else { voffA0[i] = (unsigned)(R * K + C) * 2u; voffA1[i] = voffA0[i]; }
        { const int Rb = Epi::PERM ? ((R & ~31) + perm32(R & 31)) : R; voffB[i] = (unsigned)(Rb * K + C) * 2u; } }
    const size_t kstep = (size_t)(BK * 2);
    const size_t hstep = (size_t)HALF * K * 2;
    const size_t tstep = 2 * hstep;
    const unsigned ldsw = (unsigned)wid * 1024u;
    const int aoff = lds_byte(wr * 64 + fr, fq * 8), boff = lds_byte(wc * 32 + fr, fq * 8);
#define PG8_SA(b, h) (((b) * 2 + (h)) * HTB)
#define PG8_SB(b, h) ((4 + (b) * 2 + (h)) * HTB)
#define PG8_STAGE(bufoff, gbase, voff) do { _Pragma("unroll") for (int _i = 0; _i < 2; ++_i) \
        __builtin_amdgcn_global_load_lds((const unsigned*)((const char*)(gbase) + (voff)[_i]), (LAS unsigned*)(lds + (bufoff) + ldsw + _i * 8192), 16, 0, 0); } while (0)
#define PG8_STAGE_A(bufoff, gbase, h) do { if constexpr (GATHER) { if (h) PG8_STAGE(bufoff, gbase, voffA1); else PG8_STAGE(bufoff, gbase, voffA0); } \
        else { PG8_STAGE(bufoff, (gbase) + (h) * hstep, voffA0); } } while (0)
#define PG8_LDA(dst, b, h) do { _Pragma("unroll") for (int m = 0; m < 4; ++m) _Pragma("unroll") for (int k = 0; k < 2; ++k) dst[m][k] = *(const LAS bf16x8*)(lds + PG8_SA(b, h) + aoff + m * 2048 + k * 1024); } while (0)
#define PG8_LDB(dst, b, h) do { _Pragma("unroll") for (int n = 0; n < 2; ++n) _Pragma("unroll") for (int k = 0; k < 2; ++k) dst[n][k] = *(const LAS bf16x8*)(lds + PG8_SB(b, h) + boff + n * 2048 + k * 1024); } while (0)
#define PG8_MMA(ai, bj, At, Bt) do { __builtin_amdgcn_s_setprio(1); _Pragma("unroll") for (int m = 0; m < 4; ++m) _Pragma("unroll") for (int n = 0; n < 2; ++n) _Pragma("unroll") for (int k = 0; k < 2; ++k) \
        acc[ai][bj][m][n] = SWAP ? __builtin_amdgcn_mfma_f32_16x16x32_bf16(At[m][k], Bt[n][k], acc[ai][bj][m][n], 0, 0, 0) \
                                 : __builtin_amdgcn_mfma_f32_16x16x32_bf16(Bt[n][k], At[m][k], acc[ai][bj][m][n], 0, 0, 0); __builtin_amdgcn_s_setprio(0); } while (0)
#define PG8_WAIT_V(n) asm volatile("s_waitcnt vmcnt(" #n ")" ::: "memory")
#define PG8_WAIT_L(n) asm volatile("s_waitcnt lgkmcnt(" #n ")" ::: "memory")
#define PG8_BAR __builtin_amdgcn_s_barrier()
#define PG8_SCHED __builtin_amdgcn_sched_barrier(0)
    Unit cur, nxt; int ui = 0;
    if (!S.next(0, cur)) return;
    f32x4 acc[2][2][4][2];
#pragma unroll
    for (int a = 0; a < 2; ++a)
#pragma unroll
        for (int b = 0; b < 2; ++b)
#pragma unroll
            for (int m = 0; m < 4; ++m)
#pragma unroll
                for (int n = 0; n < 2; ++n) acc[a][b][m][n] = (f32x4){0.f, 0.f, 0.f, 0.f};
    bf16x8 At[4][2], B0[2][2], B1[2][2];
    const char* cA = (const char*)g.A + (GATHER ? (size_t)0 : (size_t)cur.pm * tstep); const char* cB = (const char*)g.Bt + (size_t)cur.pn * tstep;
    PG8_STAGE(PG8_SB(0, 0), cB, voffB); PG8_STAGE(PG8_SB(0, 1), cB + hstep, voffB); PG8_STAGE_A(PG8_SA(0, 0), cA, 0); PG8_STAGE_A(PG8_SA(0, 1), cA, 1);
    if (wr == 1) PG8_BAR;
    PG8_WAIT_V(2); PG8_BAR;
    PG8_STAGE(PG8_SB(1, 0), cB + kstep, voffB); PG8_STAGE_A(PG8_SA(1, 0), cA + kstep, 0); PG8_STAGE(PG8_SB(1, 1), cB + hstep + kstep, voffB);
    PG8_WAIT_V(6); PG8_BAR;
    for (;;) {
        const bool has_next = S.next(ui + 1, nxt);
        const char* nA = has_next ? (const char*)g.A + (GATHER ? (size_t)0 : (size_t)nxt.pm * tstep) : cA; const char* nB = has_next ? (const char*)g.Bt + (size_t)nxt.pn * tstep : cB;
        for (int t = 0; t < nt; t += 2) {
            const bool last = (t == nt - 2);
            const char* a1 = cA + (size_t)(t + 1) * kstep;
            const char* a2 = last ? nA : cA + (size_t)(t + 2) * kstep; const char* b2 = last ? nB : cB + (size_t)(t + 2) * kstep;
            const char* a3 = a2 + kstep; const char* b3 = b2 + kstep;
            PG8_LDB(B0, 0, 0); PG8_LDB(B1, 0, 1); PG8_SCHED; PG8_LDA(At, 0, 0); PG8_STAGE_A(PG8_SA(1, 1), a1, 1);
            PG8_WAIT_V(8); PG8_WAIT_L(0); PG8_BAR; PG8_MMA(0, 0, At, B0); PG8_MMA(0, 1, At, B1); PG8_BAR; PG8_SCHED;
            PG8_LDA(At, 0, 1); PG8_STAGE(PG8_SB(0, 0), b2, voffB); PG8_STAGE(PG8_SB(0, 1), b2 + hstep, voffB); PG8_STAGE_A(PG8_SA(0, 0), a2, 0);
            PG8_WAIT_V(8); PG8_WAIT_L(0); PG8_BAR; PG8_MMA(1, 0, At, B0); PG8_MMA(1, 1, At, B1); PG8_BAR; PG8_SCHED;
            PG8_LDB(B0, 1, 0); PG8_LDB(B1, 1, 1); PG8_SCHED; PG8_LDA(At, 1, 0); PG8_STAGE_A(PG8_SA(0, 1), a2, 1);
            PG8_WAIT_V(8); PG8_WAIT_L(0); PG8_BAR; PG8_MMA(0, 0, At, B0); PG8_MMA(0, 1, At, B1); PG8_BAR; PG8_SCHED;
            PG8_LDA(At, 1, 1); PG8_STAGE(PG8_SB(1, 0), b3, voffB); PG8_STAGE(PG8_SB(1, 1), b3 + hstep, voffB); PG8_STAGE_A(PG8_SA(1, 0), a3, 0);
            PG8_WAIT_V(8); PG8_WAIT_L(0); PG8_BAR; PG8_MMA(1, 0, At, B0); PG8_MMA(1, 1, At, B1); PG8_BAR; PG8_SCHED;
        }
        if (PG8_ALIGN_EPI) { if (wr == 0) PG8_BAR; }
        if (REP_EPI == 1 || !Epi::IDEM) E(acc, cur, wr, wc, fr, fq);
        else { int nrep_ = REP_EPI; asm volatile("" : "+s"(nrep_)); _Pragma("nounroll") for (int re_ = 0; re_ < nrep_; ++re_) { E(acc, cur, wr, wc, fr, fq); asm volatile("" ::: "memory"); } }
        if (!has_next) break;
#pragma unroll
        for (int a = 0; a < 2; ++a)
#pragma unroll
            for (int b = 0; b < 2; ++b)
#pragma unroll
                for (int m = 0; m < 4; ++m)
#pragma unroll
                    for (int n = 0; n < 2; ++n) acc[a][b][m][n] = (f32x4){0.f, 0.f, 0.f, 0.f};
        cur = nxt; cA = nA; cB = nB; ++ui;
        if (PG8_ALIGN_EPI) { if (wr == 1) PG8_BAR; }
    }
    PG8_WAIT_V(0);
    if (!PG8_ALIGN_EPI) { if (wr == 0) PG8_BAR; }
    PG8_BAR;
#undef PG8_SA
#undef PG8_SB
#undef PG8_STAGE
#undef PG8_STAGE_A
#undef PG8_LDA
#undef PG8_LDB
#undef PG8_MMA
#undef PG8_WAIT_V
#undef PG8_WAIT_L
#undef PG8_BAR
#undef PG8_SCHED
}
}

typedef f32x4 AccT[2][2][4][2];

struct EpiPR {
    static constexpr bool PERM = false;
    static constexpr bool IDEM = true;
    bf16_t* prt; bf16_t* prtc;
    DI void operator()(const AccT& acc, const pg8::Unit& u, int wr, int wc, int fr, int fq) const {
        const bool isx = u.pm < NX / 256;
#pragma unroll
        for (int ai = 0; ai < 2; ++ai)
#pragma unroll
            for (int m = 0; m < 4; ++m) {
                const int row = u.pm * 256 + ai * 128 + wr * 64 + m * 16 + fq * 4;
#pragma unroll
                for (int bj = 0; bj < 2; ++bj)
#pragma unroll
                    for (int n = 0; n < 2; ++n) {
                        const int col = u.pn * 256 + bj * 128 + wc * 32 + n * 16 + fr;
                        const int part = col >> 9, gl = col & 511;
                        const f32x4 v = acc[ai][bj][m][n];
                        u32x2 w; w.x = pk2(v[0], v[1]); w.y = pk2(v[2], v[3]);
                        if (isx) { const int b = row >> 12, nn = row & 4095; *(u32x2*)(prt + ((size_t)((b * 2 + part) * 512 + gl) * 4096 + nn)) = w; }
                        else { const int rc = row - NX, b = rc >> 8, nn = rc & 255; *(u32x2*)(prtc + ((size_t)((b * 512 + gl) * 2 + part) * 256 + nn)) = w; }
                    }
            }
    }
};
template <int LAYER> struct EpiQKV {
    static constexpr bool PERM = true;
    static constexpr bool IDEM = true;
    bf16_t* qkv; const float* qg; const float* kg; const float* ropec; const float* ropes;
    DI void operator()(const AccT& acc, const pg8::Unit& u, int wr, int wc, int fr, int fq) const {
        constexpr int pitch = LAYER == 0 ? 768 : 3072;
        int kind;
        if (LAYER == 0) kind = u.pn < 2 ? 0 : (wc < 2 ? 1 : 2); else kind = u.pn < 4 ? 0 : (u.pn < 8 ? 1 : 2);
        const bool isx = u.pm < NX / 256;
        const bool rope = (LAYER == 0) && isx && kind < 2;
        f32x4 gv[2][2];
        if (kind < 2) { const float* gp = kind == 0 ? qg : kg;
#pragma unroll
            for (int bj = 0; bj < 2; ++bj)
#pragma unroll
                for (int n = 0; n < 2; ++n) gv[bj][n] = *(const f32x4*)(gp + bj * 32 + fq * 8 + n * 4); }
        const float osc = kind == 0 ? QSCALE : 1.f;
#pragma unroll
        for (int ai = 0; ai < 2; ++ai)
#pragma unroll
            for (int m = 0; m < 4; ++m) {
                const int row = u.pm * 256 + ai * 128 + wr * 64 + m * 16 + fr;
                f32x4 v[2][2];
#pragma unroll
                for (int bj = 0; bj < 2; ++bj)
#pragma unroll
                    for (int n = 0; n < 2; ++n) v[bj][n] = acc[ai][bj][m][n];
                if (kind < 2) {
                    float ss = 0.f;
#pragma unroll
                    for (int bj = 0; bj < 2; ++bj)
#pragma unroll
                        for (int n = 0; n < 2; ++n) { const f32x4 x = v[bj][n]; ss += (x[0] * x[0] + x[1] * x[1]) + (x[2] * x[2] + x[3] * x[3]); }
                    ss = xrow_sum(ss);
                    const float rstd = 1.0f / sqrtf(ss * (1.0f / 64.0f) + 1e-6f);
#pragma unroll
                    for (int bj = 0; bj < 2; ++bj)
#pragma unroll
                        for (int n = 0; n < 2; ++n) v[bj][n] = (v[bj][n] * rstd) * gv[bj][n];
                    if (rope) {
                        const int t = row & 4095;
#pragma unroll
                        for (int n = 0; n < 2; ++n) {
                            const f32x4 c = *(const f32x4*)(ropec + t * 32 + fq * 8 + n * 4), s = *(const f32x4*)(ropes + t * 32 + fq * 8 + n * 4);
                            const f32x4 x1 = v[0][n], x2 = v[1][n];
                            v[0][n] = x1 * c - x2 * s; v[1][n] = x1 * s + x2 * c;
                        }
                    }
                }
                bf16_t* op = qkv + (size_t)row * pitch + u.pn * 256 + wc * 64 + fq * 8;
#pragma unroll
                for (int bj = 0; bj < 2; ++bj) { const f32x4 x = v[bj][0] * osc, z = v[bj][1] * osc; u32x4 w; w.x = pk2(x[0], x[1]); w.y = pk2(x[2], x[3]); w.z = pk2(z[0], z[1]); w.w = pk2(z[2], z[3]); *(u32x4*)(op + bj * 32) = w; }
                if (m & 1) asm volatile("" ::: "memory");
            }
    }
};
struct EpiFourier {
    static constexpr bool PERM = true;
    static constexpr bool IDEM = true;
    bf16_t* att; int rowbase, rows_per_b;
    DI void operator()(const AccT& acc, const pg8::Unit& u, int wr, int wc, int fr, int fq) const {
        const int b = u.pn >> 1, colbase = (u.pn & 1) * 256 + wc * 32 + fq * 8;
#pragma unroll
        for (int ai = 0; ai < 2; ++ai)
#pragma unroll
            for (int m = 0; m < 4; ++m) {
                const int row = rowbase + b * rows_per_b + u.pm * 256 + ai * 128 + wr * 64 + m * 16 + fr;
                bf16_t* op = att + (size_t)row * D + colbase;
#pragma unroll
                for (int bj = 0; bj < 2; ++bj) { const f32x4 x = acc[ai][bj][m][0], y = acc[ai][bj][m][1]; u32x4 w; w.x = pk2(x[0], x[1]); w.y = pk2(x[2], x[3]); w.z = pk2(y[0], y[1]); w.w = pk2(y[2], y[3]); *(u32x4*)(op + bj * 128) = w; }
            }
    }
};
struct EpiUV {
    static constexpr int NVM = 0;
    static constexpr bool PERM = true;
    static constexpr bool IDEM = true;
    bf16_t* uv;
    DI void operator()(const AccT& acc, const pg8::Unit& u, int wr, int wc, int fr, int fq) const {
        const int bp = u.pn >> 1, colbase = (u.pn & 1) * 256 + wc * 32 + fq * 8, kt = u.pm & 7;
#pragma unroll
        for (int ai = 0; ai < 2; ++ai)
#pragma unroll
            for (int m = 0; m < 4; ++m) {
                const int k = kt * 256 + ai * 128 + wr * 64 + m * 16 + fr;
                bf16_t* op = uv + ((size_t)bp * 2048 + k) * 512 + colbase;
#pragma unroll
                for (int bj = 0; bj < 2; ++bj) { const f32x4 x = acc[ai][bj][m][0], y = acc[ai][bj][m][1]; u32x4 w; w.x = pk2(x[0], x[1]); w.y = pk2(x[2], x[3]); w.z = pk2(y[0], y[1]); w.w = pk2(y[2], y[3]); *(u32x4*)(op + bj * 128) = w; }
            }
    }
};
struct FourierSched {
    pg8::StaticOrder so;
    DI bool next(int i, pg8::Unit& u) const { if (!so.next(i, u)) return false; u.pm += 8 * ((u.pn >> 1) & 1); return true; }
};
struct EpiOut {
    static constexpr bool PERM = true;
    static constexpr bool IDEM = false;
    const float* xin; float* xout; const float* cin; float* cout; const float* mod;
    DI void operator()(const AccT& acc, const pg8::Unit& u, int wr, int wc, int fr, int fq) const {
        const bool isx = u.pm < NX / 256;
        const int col0 = u.pn * 256 + wc * 32 + fq * 8;
        const int s = isx ? (u.pm >> 4) : 16;
        const float* gp = mod + (size_t)s * 6144 + 2 * 1024 + col0;
        f32x4 gv[2][2];
#pragma unroll
        for (int bj = 0; bj < 2; ++bj)
#pragma unroll
            for (int n = 0; n < 2; ++n) gv[bj][n] = *(const f32x4*)(gp + bj * 128 + n * 4);
#pragma unroll
        for (int ai = 0; ai < 2; ++ai)
#pragma unroll
            for (int m = 0; m < 4; ++m) {
                const int row = u.pm * 256 + ai * 128 + wr * 64 + m * 16 + fr;
                const size_t off = isx ? (size_t)row * D + col0 : (size_t)(row - NX) * D + col0;
                const float* ip = (isx ? xin : cin) + off; float* op = (isx ? xout : cout) + off;
#pragma unroll
                for (int bj = 0; bj < 2; ++bj)
#pragma unroll
                    for (int n = 0; n < 2; ++n) { const f32x4 x = *(const f32x4*)(ip + bj * 128 + n * 4);
                        *(f32x4*)(op + bj * 128 + n * 4) = x + gv[bj][n] * acc[ai][bj][m][n]; }
            }
    }
};
struct EpiGU {
    static constexpr bool PERM = true;
    static constexpr bool IDEM = true;
    bf16_t* act;
    DI void operator()(const AccT& acc, const pg8::Unit& u, int wr, int wc, int fr, int fq) const {
#pragma unroll
        for (int ai = 0; ai < 2; ++ai)
#pragma unroll
            for (int m = 0; m < 4; ++m) {
                const int slot = u.pm * 256 + ai * 128 + wr * 64 + m * 16 + fr;
                bf16_t* op = act + (size_t)slot * D + u.pn * 128 + wc * 32 + fq * 8;
                f32x4 r[2];
#pragma unroll
                for (int n = 0; n < 2; ++n) { const f32x4 a = acc[ai][0][m][n], up = acc[ai][1][m][n];
#pragma unroll
                    for (int j = 0; j < 4; ++j) r[n][j] = a[j] * up[j] * __builtin_amdgcn_rcpf(1.0f + __expf(-a[j])); }
                { u32x4 w; w.x = pk2(r[0][0], r[0][1]); w.y = pk2(r[0][2], r[0][3]); w.z = pk2(r[1][0], r[1][1]); w.w = pk2(r[1][2], r[1][3]); *(u32x4*)op = w; }
            }
    }
};
struct EpiDown {
    static constexpr bool PERM = true;
    static constexpr bool IDEM = true;
    bf16_t* y; int slot0;
    DI void operator()(const AccT& acc, const pg8::Unit& u, int wr, int wc, int fr, int fq) const {
        const int col0 = u.pn * 256 + wc * 32 + fq * 8;
#pragma unroll
        for (int ai = 0; ai < 2; ++ai)
#pragma unroll
            for (int m = 0; m < 4; ++m) {
                const int slot = slot0 + ai * 128 + wr * 64 + m * 16 + fr;
                bf16_t* op = y + (size_t)slot * D + col0;
#pragma unroll
                for (int bj = 0; bj < 2; ++bj) { const f32x4 x = acc[ai][bj][m][0], z = acc[ai][bj][m][1]; u32x4 w; w.x = pk2(x[0], x[1]); w.y = pk2(x[2], x[3]); w.z = pk2(z[0], z[1]); w.w = pk2(z[2], z[3]); *(u32x4*)(op + bj * 128) = w; }
            }
    }
};

constexpr int AL_K = 0, AL_V = 32768, AL_WS = 65536, AL_OST = 67584, AL_RPB = 100352;
DI int crow(int r, int hi) { return (r & 3) + 8 * (r >> 2) + 4 * hi; }
#define MFMA32(a, b, c) __builtin_amdgcn_mfma_f32_32x32x16_bf16((a), (b), (c), 0, 0, 0)
typedef short v4i16_t __attribute__((ext_vector_type(4)));
DI s16x4 vtr(const LAS unsigned char* p) { return __builtin_bit_cast(s16x4, __builtin_amdgcn_ds_read_tr16_b64_v4i16((LAS v4i16_t*)p)); }

DI float score_bound(const float* qgain, const float* kgain, const float* rpb, int nrpb, const float* sinkp, int nsink, int lane) {
    float gq = fabsf(qgain[lane]), gk = fabsf(kgain[lane]); gq = xrow_max(row16_max(gq)); gk = xrow_max(row16_max(gk));
    float sb = 8.0f * gq * gk * (LOG2E * 1.02f), ex_ = 0.f;
    if (rpb) { float bm = 0.f; for (int i = lane; i < nrpb; i += 64) bm = fmaxf(bm, fabsf(rpb[i])); bm = xrow_max(row16_max(bm)); sb += bm * LOG2E; }
    if (sinkp) { float sm_ = lane < nsink ? fabsf(sinkp[lane]) : 0.f; ex_ = xrow_max(row16_max(sm_)) * LOG2E; }
    const bool ok = (sb <= 60.0f) && (ex_ <= 60.0f);
    return ok ? sb : -1.0f;
}
template <int MODE>
DI void attn_unit(int unit, const bf16_t* __restrict__ qkv, bf16_t* att, const float* sinkp, const float* rpb, float sbound, LAS unsigned char* lds, int wid_s) {
    const int tid = opaque_tid(wid_s), lane = tid & 63, r32 = lane & 31, hi = lane >> 5, wid = __builtin_amdgcn_readfirstlane(tid >> 6);
    constexpr int pitch = MODE == 2 ? 3072 : 768;
    int b, qrow, qcol, kcol, vcol, ocol, nT, loc0 = 0, head;
    int qblk = 0, r0 = 0, c0 = 0, qr_l = 0, rs_l = 0, qc = 0, cs = 0, rs_lo = 0, rs_hi = 0;
    if (MODE == 0) { b = unit >> 7; const int kvh = (unit >> 6) & 1; qblk = unit & 63; head = kvh * 4 + (wid >> 1);
        qrow = b * SEQ + qblk * 64 + 32 * (wid & 1) + r32; qcol = head * 64; kcol = 512 + kvh * 64; vcol = 640 + kvh * 64; ocol = 512 + head * 64;
        const int lo = qblk - 2 < 0 ? 0 : qblk - 2, hi_ = qblk + 2 > 63 ? 63 : qblk + 2; loc0 = lo; nT = 4 + (hi_ - lo + 1); }
    else if (MODE == 1) { b = unit >> 3; const int kvh = (unit >> 2) & 1, qb = unit & 3; head = kvh * 4 + (wid >> 1);
        qrow = NX + b * LC + qb * 64 + 32 * (wid & 1) + r32; qcol = head * 64; kcol = 512 + kvh * 64; vcol = 640 + kvh * 64; ocol = 512 + head * 64; nT = 4; }
    else { b = unit >> 8; head = (unit >> 4) & 15; const int i4 = unit & 15, jg = wid & 3; r0 = 4 * i4 + 2 * (wid >> 2);
        qr_l = r0 + (r32 >> 4); qc = 16 * jg + (r32 & 15);
        qrow = b * SEQ + 64 * qr_l + qc; qcol = head * 64; kcol = 1024 + head * 64; vcol = 2048 + head * 64; ocol = head * 64;
        int lo = 4 * i4 - 4; lo = lo < 0 ? 0 : (lo > 56 ? 56 : lo); int h2 = 4 * i4 - 1; h2 = h2 < 0 ? 0 : (h2 > 56 ? 56 : h2); loc0 = lo; nT = 4 + (h2 + 7 - lo + 1);
        c0 = 16 * jg - 8; c0 = c0 < 0 ? 0 : (c0 > 32 ? 32 : c0);
        rs_l = qr_l - 4; rs_l = rs_l < 0 ? 0 : (rs_l > 56 ? 56 : rs_l);
        rs_lo = r0 - 4; rs_lo = rs_lo < 0 ? 0 : (rs_lo > 56 ? 56 : rs_lo); rs_hi = r0 - 3; rs_hi = rs_hi < 0 ? 0 : (rs_hi > 56 ? 56 : rs_hi);
        cs = qc - 8; cs = cs < 0 ? 0 : (cs > 48 ? 48 : cs); }
    const int ctxrow0 = NX + b * LC;
    auto tile_row = [&](int t) -> int { return t < 4 ? ctxrow0 + 64 * t : b * SEQ + 64 * (loc0 + t - 4); };
    const int lkey = tid >> 3, lc = tid & 7;
    const int kdst = lc * 1024 + lkey * 16, vdst = ((lc >> 2) * 4 + (lkey >> 4)) * 1024 + (lkey & 15) * 64 + (lc & 3) * 16;
    LAS float* wsf = (LAS float*)(lds + AL_WS) + wid * 64;
    LAS float* rpbl = (LAS float*)(lds + AL_RPB);
    unsigned boff[4] = {0u, 0u, 0u, 0u};
    if (MODE == 2) { { const int rr_ = tid >> 5, cc_ = tid & 31; rpbl[tid] = (rr_ < 15 && cc_ < 31) ? rpb[head * 465 + rr_ * 31 + cc_] * LOG2E : -INFINITY; }
#pragma unroll
        for (int i = 0; i < 16; ++i) { const int kc = c0 + crow(i, hi); int ix = kc - qc + 15; ix = ix < 0 ? 0 : (ix > 30 ? 30 : ix); boff[i >> 2] |= (unsigned)((((unsigned)(kc - cs) < 16u) ? ix : 31) * 4) << (8 * (i & 3)); } }
    const int nS = (nT + 1) >> 1;
    u32x4 kA[2], vA[2], kB[2], vB[2];
    auto issue_loads = [&](int step, u32x4 (&kr_)[2], u32x4 (&vr_)[2]) {
#pragma unroll
        for (int sb = 0; sb < 2; ++sb) { int tt = 2 * step + sb; tt = tt < nT ? tt : nT - 1; const bf16_t* src = qkv + (size_t)(tile_row(tt) + lkey) * pitch + lc * 8; kr_[sb] = *(const u32x4*)(src + kcol); vr_[sb] = *(const u32x4*)(src + vcol); } };
    auto write_lds = [&](int step, const u32x4 (&kr_)[2], const u32x4 (&vr_)[2]) { const int nb = (step & 1) * 16384;
#pragma unroll
        for (int sb = 0; sb < 2; ++sb) { *(LAS u32x4*)(lds + AL_K + nb + sb * 8192 + kdst) = kr_[sb]; *(LAS u32x4*)(lds + AL_V + nb + sb * 8192 + vdst) = vr_[sb]; } };
    issue_loads(0, kA, vA);
    if (nS > 1) issue_loads(1, kB, vB);
    bf16x8 qr[4];
#pragma unroll
    for (int d0 = 0; d0 < 4; ++d0) qr[d0] = *(const bf16x8*)(qkv + (size_t)qrow * pitch + qcol + d0 * 16 + hi * 8);
    write_lds(0, kA, vA);
    f32x16 o0, o1;
#pragma unroll
    for (int i = 0; i < 16; ++i) { o0[i] = 0.f; o1[i] = 0.f; }
    float mref = 0.f, lsum = 0.f;
    const bool fast = __builtin_amdgcn_readfirstlane(sbound >= 0.f ? 1 : 0) != 0;
    if (fast) mref = sbound;
    const int qoff = 32 * (wid & 1) + r32;
    const int i16 = lane & 15, vrd = (4 * hi + (i16 >> 2)) * 64 + ((lane >> 4) & 1) * 32 + (i16 & 3) * 8;
    int vlo2 = 0, vhi2 = 0;
    if (MODE == 2) { const int k0_ = c0 + 4 * hi + (i16 >> 2), k1_ = k0_ + 8; const int bo = ((lane >> 4) & 1) * 32 + (i16 & 3) * 8;
        vlo2 = (k0_ >> 4) * 1024 + (k0_ & 15) * 64 + bo; vhi2 = (k1_ >> 4) * 1024 + (k1_ & 15) * 64 + bo; }
#define ATT_RESCALE(rm_, delta_) do { delta_ = 0.f; if (t == 0) { delta_ = (rm_); mref = (rm_); } else if (__any((rm_) > 8.0f)) { \
        delta_ = fmaxf((rm_), 0.f); const float f = __builtin_amdgcn_exp2f(-delta_); lsum *= f; mref += delta_; \
        if (hi == 0) wsf[r32] = f; \
        asm volatile("s_waitcnt lgkmcnt(0)" ::: "memory"); \
        _Pragma("unroll") for (int i = 0; i < 16; ++i) { const float fr_ = wsf[crow(i, hi)]; o0[i] *= fr_; o1[i] *= fr_; } \
        asm volatile("s_waitcnt lgkmcnt(0)" ::: "memory"); } } while (0)
    auto compute_step = [&](int st) {
#pragma unroll 1
        for (int sub = 0; sub < 2; ++sub) {
        const int t = 2 * st + sub;
        if (t >= nT) break;
        bool active = true; int kr = 0;
        if (MODE == 2 && t >= 4) { kr = loc0 + t - 4; active = (kr >= rs_lo) && (kr < rs_hi + 8); }
        if (active) {
            const LAS unsigned char* Kb = lds + AL_K + (st & 1) * 16384 + sub * 8192; const LAS unsigned char* Vb = lds + AL_V + (st & 1) * 16384 + sub * 8192;
            if (MODE == 2 && t >= 4) {
                f32x16 p0; const float nm = -mref;
#pragma unroll
                for (int i = 0; i < 16; ++i) p0[i] = nm;
#pragma unroll
                for (int d0 = 0; d0 < 4; ++d0) { const bf16x8 k0 = *(const LAS bf16x8*)(Kb + (2 * d0 + hi) * 1024 + (c0 + r32) * 16); p0 = MFMA32(k0, qr[d0], p0); }
                { int dr = kr - qr_l + 7; dr = ((unsigned)(kr - rs_l) < 8u) ? (dr < 0 ? 0 : (dr > 14 ? 14 : dr)) : 15; const LAS unsigned char* bp = lds + AL_RPB + dr * 128;
#pragma unroll
                  for (int i = 0; i < 16; ++i) p0[i] += *(const LAS float*)(bp + ((boff[i >> 2] >> (8 * (i & 3))) & 0xffu)); }
                if (!fast) {
                float rm = p0[0];
#pragma unroll
                for (int i = 1; i < 16; ++i) rm = fmaxf(rm, p0[i]);
                { auto r_ = __builtin_amdgcn_permlane32_swap(__float_as_uint(rm), __float_as_uint(rm), false, false); rm = fmaxf(__uint_as_float(r_[0]), __uint_as_float(r_[1])); }
                float dl; ATT_RESCALE(rm, dl);
                if (__any(dl != 0.f)) {
#pragma unroll
                    for (int i = 0; i < 16; ++i) p0[i] -= dl; }
                }
                f32x2_t ls2 = (f32x2_t){0.f, 0.f};
#pragma unroll
                for (int i = 0; i < 16; i += 2) { p0[i] = __builtin_amdgcn_exp2f(p0[i]); p0[i + 1] = __builtin_amdgcn_exp2f(p0[i + 1]); ls2 += (f32x2_t){p0[i], p0[i + 1]}; }
                lsum += ls2[0] + ls2[1];
#pragma unroll
                for (int ks = 0; ks < 2; ++ks) {
                    u32x4 w; w.x = pk2(p0[8 * ks + 0], p0[8 * ks + 1]); w.y = pk2(p0[8 * ks + 2], p0[8 * ks + 3]); w.z = pk2(p0[8 * ks + 4], p0[8 * ks + 5]); w.w = pk2(p0[8 * ks + 6], p0[8 * ks + 7]);
                    const bf16x8 pa = __builtin_bit_cast(bf16x8, w);
#pragma unroll
                    for (int d0 = 0; d0 < 2; ++d0) {
                        const s16x4 lo = vtr(Vb + d0 * 4096 + ks * 1024 + vlo2), hh = vtr(Vb + d0 * 4096 + ks * 1024 + vhi2);
                        const bf16x8 vf = (bf16x8){lo[0], lo[1], lo[2], lo[3], hh[0], hh[1], hh[2], hh[3]};
                        if (d0 == 0) o0 = MFMA32(pa, vf, o0); else o1 = MFMA32(pa, vf, o1);
                    }
                }
            } else {
            f32x16 p0, p1; const float nm = -mref;
#pragma unroll
            for (int i = 0; i < 16; ++i) { p0[i] = nm; p1[i] = nm; }
#pragma unroll
            for (int d0 = 0; d0 < 4; ++d0) {
                const bf16x8 k0 = *(const LAS bf16x8*)(Kb + (2 * d0 + hi) * 1024 + r32 * 16), k1 = *(const LAS bf16x8*)(Kb + (2 * d0 + hi) * 1024 + r32 * 16 + 512);
                p0 = MFMA32(k0, qr[d0], p0); p1 = MFMA32(k1, qr[d0], p1);
            }
            if (MODE == 0 && t >= 4) {
                const int kt = loc0 + t - 4;
                if (kt == qblk - 2) {
#pragma unroll
                    for (int i = 0; i < 16; ++i) { const int key = crow(i, hi); if (key < qoff) p0[i] = -INFINITY; if (key + 32 < qoff) p1[i] = -INFINITY; }
                } else if (kt == qblk + 2) {
#pragma unroll
                    for (int i = 0; i < 16; ++i) { const int key = crow(i, hi); if (key > qoff) p0[i] = -INFINITY; if (key + 32 > qoff) p1[i] = -INFINITY; }
                }
            }
            if (!fast) {
            float rm = fmaxf(p0[0], p1[0]);
#pragma unroll
            for (int i = 1; i < 16; ++i) rm = fmaxf(rm, fmaxf(p0[i], p1[i]));
            { auto r_ = __builtin_amdgcn_permlane32_swap(__float_as_uint(rm), __float_as_uint(rm), false, false); rm = fmaxf(__uint_as_float(r_[0]), __uint_as_float(r_[1])); }
            float dl; ATT_RESCALE(rm, dl);
            if (__any(dl != 0.f)) {
#pragma unroll
                for (int i = 0; i < 16; ++i) { p0[i] -= dl; p1[i] -= dl; } }
            }
            f32x2_t ls2 = (f32x2_t){0.f, 0.f};
#pragma unroll
            for (int i = 0; i < 16; ++i) { p0[i] = __builtin_amdgcn_exp2f(p0[i]); p1[i] = __builtin_amdgcn_exp2f(p1[i]); ls2 += (f32x2_t){p0[i], p1[i]}; }
            lsum += ls2[0] + ls2[1];
            bf16x8 pa[4];
#pragma unroll
            for (int ks = 0; ks < 4; ++ks) {
                u32x4 w;
                if (ks < 2) { w.x = pk2(p0[8 * ks + 0], p0[8 * ks + 1]); w.y = pk2(p0[8 * ks + 2], p0[8 * ks + 3]); w.z = pk2(p0[8 * ks + 4], p0[8 * ks + 5]); w.w = pk2(p0[8 * ks + 6], p0[8 * ks + 7]); }
                else { const int k2 = ks - 2; w.x = pk2(p1[8 * k2 + 0], p1[8 * k2 + 1]); w.y = pk2(p1[8 * k2 + 2], p1[8 * k2 + 3]); w.z = pk2(p1[8 * k2 + 4], p1[8 * k2 + 5]); w.w = pk2(p1[8 * k2 + 6], p1[8 * k2 + 7]); }
                pa[ks] = __builtin_bit_cast(bf16x8, w);
            }
#pragma unroll
            for (int ks = 0; ks < 4; ++ks) {
#pragma unroll
                for (int d0 = 0; d0 < 2; ++d0) {
                    const LAS unsigned char* vp = Vb + (d0 * 4 + ks) * 1024 + vrd;
                    const s16x4 lo = vtr(vp), hh = vtr(vp + 512);
                    const bf16x8 vf = (bf16x8){lo[0], lo[1], lo[2], lo[3], hh[0], hh[1], hh[2], hh[3]};
                    if (d0 == 0) o0 = MFMA32(pa[ks], vf, o0); else o1 = MFMA32(pa[ks], vf, o1);
                }
            }
            }
        }
        }
    };
    for (int st = 0; st < nS; st += 2) {
        __syncthreads();
        if (st + 2 < nS) issue_loads(st + 2, kA, vA);
        compute_step(st);
        if (st + 1 < nS) {
            write_lds(st + 1, kB, vB);
            __syncthreads();
            if (st + 3 < nS) issue_loads(st + 3, kB, vB);
            compute_step(st + 1);
            if (st + 2 < nS) write_lds(st + 2, kA, vA);
        }
    }
#undef ATT_RESCALE
    { auto r_ = __builtin_amdgcn_permlane32_swap(__float_as_uint(lsum), __float_as_uint(lsum), false, false); lsum = __uint_as_float(r_[0]) + __uint_as_float(r_[1]); }
    if (MODE != 2) lsum += __builtin_amdgcn_exp2f(sinkp[head] * LOG2E - mref);
    const float inv = 1.0f / lsum;
    if (hi == 0) wsf[32 + r32] = inv;
    asm volatile("s_waitcnt lgkmcnt(0)" ::: "memory");
    LAS bf16_t* stg = (LAS bf16_t*)(lds + AL_OST) + wid * 2048;
#pragma unroll
    for (int i = 0; i < 16; ++i) { const int orow = crow(i, hi); const float iv = wsf[32 + orow];
        stg[orow * 64 + r32] = (bf16_t)(pk2(o0[i] * iv, 0.f) & 0xffffu); stg[orow * 64 + 32 + r32] = (bf16_t)(pk2(o1[i] * iv, 0.f) & 0xffffu); }
    asm volatile("s_waitcnt lgkmcnt(0)" ::: "memory");
    const int qrow_w = qrow - r32 * (MODE == 2 ? 0 : 1);
#pragma unroll
    for (int i = 0; i < 4; ++i) { const int row = i * 8 + (lane >> 3), ch = lane & 7; const u32x4 v = *(const LAS u32x4*)(stg + row * 64 + ch * 8);
        size_t tok;
        if (MODE == 2) tok = (size_t)b * SEQ + 64 * (r0 + (row >> 4)) + 16 * (wid & 3) + (row & 15); else tok = (size_t)qrow_w + row;
        *(u32x4*)(att + tok * D + ocol + ch * 8) = v; }
    __syncthreads();
}

#define XB_TMO      128
#define XB_XCNT(j)  (256  + 64 * (j))
#define XB_XSUB(j)  (1280 + 64 * (j))
#define XB_XGEN(j)  (2304 + 64 * (j))
#define XB_TOP      3328
#define XB_TOPGEN   3392
#define XCD_BAR_WORDS 3456
#define XB_SPIN_CAP (1u << 22)
DI unsigned xb_ld(unsigned* p)              { return __hip_atomic_load(p, __ATOMIC_RELAXED, __HIP_MEMORY_SCOPE_AGENT); }
DI unsigned xb_add(unsigned* p, unsigned v) { return __hip_atomic_fetch_add(p, v, __ATOMIC_RELAXED, __HIP_MEMORY_SCOPE_AGENT); }
DI unsigned xb_xcc_id() { return (unsigned)__builtin_amdgcn_s_getreg((3 << 11) | 20) & 0xFu; }
#define XB_SPIN(cond, bar) do { unsigned _sp = 0; while (cond) { __builtin_amdgcn_s_sleep(1); \
    if ((++_sp & 255u) == 0u) { if (xb_ld(&(bar)[XB_TMO])) break; if (_sp > XB_SPIN_CAP) { atomicAdd(&(bar)[XB_TMO], 1u); break; } } } } while (0)
DI void xcd_barrier_complete(unsigned* bar, unsigned x, unsigned& nloc, unsigned& nx) {
    const unsigned G = gridDim.x * gridDim.y * gridDim.z;
    unsigned sum, cnt, mine, sp = 0u;
    for (;;) {
        sum = 0u; cnt = 0u; mine = 0u;
#pragma unroll
        for (unsigned j = 0; j < 16; ++j) { const unsigned c = xb_ld(&bar[XB_XCNT(j)]); sum += c; cnt += (c > 0u) ? 1u : 0u; mine = (j == x) ? c : mine; }
        if (sum == G) break;
        __builtin_amdgcn_s_sleep(1);
        if ((++sp & 255u) == 0u) { if (xb_ld(&bar[XB_TMO])) break; if (sp > XB_SPIN_CAP) { atomicAdd(&bar[XB_TMO], 1u); break; } }
    }
    nloc = mine > 0u ? mine : 1u; nx = cnt > 0u ? cnt : 1u;
}
DI void xcd_barrier(unsigned* bar, volatile LAS unsigned* st) {
    asm volatile("s_waitcnt vmcnt(0)" ::: "memory");
    __syncthreads();
    if (threadIdx.x == 0) {
        const unsigned x = xb_xcc_id();
        __builtin_amdgcn_s_waitcnt(0);
        unsigned nloc = st[0], nx = st[1];
        if (nloc == 0u) { xcd_barrier_complete(bar, x, nloc, nx); st[0] = nloc; st[1] = nx; }
        const unsigned old = xb_add(&bar[XB_XSUB(x)], 1u);
        const unsigned gen = old / nloc;
        if (old + 1u == (gen + 1u) * nloc) {
            __builtin_amdgcn_fence(__ATOMIC_RELEASE, "agent");
            asm volatile("s_waitcnt vmcnt(0)" ::: "memory");
            const unsigned og = xb_add(&bar[XB_TOP], 1u);
            const unsigned tg = og / nx;
            if (og + 1u == (tg + 1u) * nx) xb_add(&bar[XB_TOPGEN], 1u);
            else XB_SPIN(xb_ld(&bar[XB_TOPGEN]) == tg, bar);
            __builtin_amdgcn_fence(__ATOMIC_ACQUIRE, "agent");
            xb_add(&bar[XB_XGEN(x)], 1u);
            asm volatile("s_waitcnt vmcnt(0)" ::: "memory");
        } else {
            XB_SPIN(xb_ld(&bar[XB_XGEN(x)]) == gen, bar);
            __builtin_amdgcn_fence(__ATOMIC_ACQUIRE, "agent");
            asm volatile("s_waitcnt vmcnt(0)" ::: "memory");
        }
    }
    __syncthreads();
}

DI void transpose_item(const float* W, int ldw, int k0, int n0, bf16_t* WT, int drowA, int drowB, LAS float* scr, int lane) {
    const int n4 = (lane & 15) * 4, kr = lane >> 4;
    f32x4 v[16];
#pragma unroll
    for (int i = 0; i < 16; ++i) v[i] = *(const f32x4*)(W + (size_t)(k0 + 4 * i + kr) * ldw + n0 + n4);
#pragma unroll
    for (int i = 0; i < 16; ++i) { LAS float* d = scr + (4 * i + kr) * 65 + n4; d[0] = v[i][0]; d[1] = v[i][1]; d[2] = v[i][2]; d[3] = v[i][3]; }
    asm volatile("s_waitcnt lgkmcnt(0)" ::: "memory");
    const int c = lane & 7;
#pragma unroll
    for (int j = 0; j < 8; ++j) { const int n = (lane >> 3) + 8 * j; const LAS float* s = scr + (8 * c) * 65 + n;
        u32x4 o; o.x = pk2(s[0 * 65], s[1 * 65]); o.y = pk2(s[2 * 65], s[3 * 65]); o.z = pk2(s[4 * 65], s[5 * 65]); o.w = pk2(s[6 * 65], s[7 * 65]);
        const int drow = n < 32 ? drowA + n : drowB + n - 32;
        *(u32x4*)(WT + (size_t)drow * 1024 + k0 + 8 * c) = o; }
    asm volatile("s_waitcnt lgkmcnt(0)" ::: "memory");
}
DI int headslot_row(int n) { const int hs = n >> 6, d0 = n & 63, pn = hs >> 2, wc = hs & 3, bj = d0 >> 5; return 256 * pn + 128 * bj + 32 * wc; }

DI int block_excl_scan(int v, LAS int* wsum, int lane, int wid, int& total) {
    int inc = v;
#pragma unroll
    for (int o = 1; o < 64; o <<= 1) { const int t = __builtin_amdgcn_ds_bpermute(((lane - o) & 63) << 2, inc); if (lane >= o) inc += t; }
    if (lane == 63) wsum[wid] = inc;
    __syncthreads();
    int base = 0, tot = 0;
#pragma unroll
    for (int w = 0; w < 8; ++w) { const int x = wsum[w]; tot += x; if (w < wid) base += x; }
    total = tot;
    __syncthreads();
    return base + inc - v;
}

DI void router_softmax_store(const float (&lg)[16], int lane, float* dst, bool doit) {
    float a8[8], a4[4];
#pragma unroll
    for (int i = 0; i < 8; ++i) { auto r = __builtin_amdgcn_permlane32_swap(__float_as_uint(lg[i]), __float_as_uint(lg[8 + i]), false, false); a8[i] = __uint_as_float(r[0]) + __uint_as_float(r[1]); }
#pragma unroll
    for (int i = 0; i < 4; ++i) { auto r = __builtin_amdgcn_permlane16_swap(__float_as_uint(a8[i]), __float_as_uint(a8[4 + i]), false, false); a4[i] = __uint_as_float(r[0]) + __uint_as_float(r[1]); }
#pragma unroll
    for (int i = 0; i < 4; ++i) a4[i] = row16_sum(a4[i]);
    float mx = fmaxf(fmaxf(a4[0], a4[1]), fmaxf(a4[2], a4[3])); mx = xrow_max(mx);
    float ex[4], sm = 0.f;
#pragma unroll
    for (int i = 0; i < 4; ++i) { ex[i] = expf(a4[i] - mx); sm += ex[i]; }
    sm = xrow_sum(sm);
    if (doit && (lane & 15) == 0) { f32x4 o; o[0] = ex[0] / sm; o[1] = ex[1] / sm; o[2] = ex[2] / sm; o[3] = ex[3] / sm; *(f32x4*)(dst + 4 * (lane >> 4)) = o; }
}

__global__ void __launch_bounds__(512, 2) fwd_kernel(Params p) {
    extern __shared__ __attribute__((aligned(16))) unsigned char lds_raw[];
    LAS unsigned char* lds = (LAS unsigned char*)lds_raw;
    cg::grid_group grid = cg::this_grid();
    const int G = gridDim.x, bid = blockIdx.x;
    const int NGW = G * 8;
    const int wid_k = __builtin_amdgcn_readfirstlane(threadIdx.x >> 6);
#define PHASE_IDS const int tid = opaque_tid(wid_k), lane = tid & 63, wid = __builtin_amdgcn_readfirstlane(tid >> 6), gw = bid * 8 + wid; (void)lane; (void)gw;
    {
        LAS unsigned long long* PT = (LAS unsigned long long*)(lds + PT_OFF);
        if (threadIdx.x == 0) {
            PT[0] = (unsigned long long)p.in[0]; PT[1] = (unsigned long long)p.in[1]; PT[2] = (unsigned long long)p.in[2]; PT[3] = (unsigned long long)p.in[3];
            PT[4] = (unsigned long long)p.in[4]; PT[5] = (unsigned long long)p.in[5]; PT[6] = (unsigned long long)p.in[6]; PT[7] = (unsigned long long)p.in[7];
            PT[8] = (unsigned long long)p.in[8]; PT[9] = (unsigned long long)p.in[9]; PT[10] = (unsigned long long)p.in[10]; PT[11] = (unsigned long long)p.in[11];
            PT[12] = (unsigned long long)p.in[12]; PT[13] = (unsigned long long)p.in[13]; PT[14] = (unsigned long long)p.in[14]; PT[15] = (unsigned long long)p.in[15];
            PT[16] = (unsigned long long)p.in[16]; PT[17] = (unsigned long long)p.in[17]; PT[18] = (unsigned long long)p.in[18]; PT[19] = (unsigned long long)p.in[19];
            PT[20] = (unsigned long long)p.in[20]; PT[21] = (unsigned long long)p.in[21]; PT[22] = (unsigned long long)p.out; PT[23] = (unsigned long long)p.ws;
            ((LAS unsigned*)(lds + PT_OFF + 192))[0] = 0u; ((LAS unsigned*)(lds + PT_OFF + 192))[1] = 0u;
            (void)xb_add((unsigned*)(p.ws + WS_BAR) + XB_XCNT(xb_xcc_id()), 1u);
        }
        __syncthreads();
    }
#define LDP(i) ldptr(lds, (i))
#define GRID_BAR() xcd_barrier((unsigned*)(WSP + WS_BAR), (volatile LAS unsigned*)(lds + PT_OFF + 192))
#define WSP ((unsigned char*)LDP(23))
#define WPR ((bf16_t*)(WSP + WS_WPR))
#define WQKV0 ((bf16_t*)(WSP + WS_WQKV0))
#define WOUT0 ((bf16_t*)(WSP + WS_WOUT0))
#define WIN1 ((bf16_t*)(WSP + WS_WIN1))
#define WOUT1 ((bf16_t*)(WSP + WS_WOUT1))
#define DFTC ((bf16_t*)(WSP + WS_DFTC))
#define MOD ((float*)(WSP + WS_MOD))
#define ROPEC ((float*)(WSP + WS_ROPE))
#define ROPES (ROPEC + 4096 * 32)
#define AFF ((float*)(WSP + WS_AFF))
#define ROWIDX ((int*)(WSP + WS_ROWIDX))
#define GATEV ((float*)(WSP + WS_GATEV))
#define WGU ((bf16_t*)(WSP + WS_WGU))
#define WDN ((bf16_t*)(WSP + WS_WDN))
#define DFT ((bf16_t*)(WSP + WS_DFT))
#define UVB ((bf16_t*)(WSP + WS_UV))
#define CSB ((float*)(WSP + WS_CS))
#define CTX1 ((float*)(WSP + WS_CTX1))
#define ACTV ((bf16_t*)(WSP + WS_ACTV))
#define QKV ((bf16_t*)(WSP + WS_QKV))
#define PRT ((bf16_t*)(WSP + WS_PRT))
#define PRTC ((bf16_t*)(WSP + WS_PRTC))
#define ACT ((bf16_t*)(WSP + WS_ACT))
#define YB ((bf16_t*)(WSP + WS_Y))
#define ACTC ((bf16_t*)(WSP + WS_ACTC))
#define CNTW ((int*)(WSP + WS_CNT))
#define INV ((int*)(WSP + WS_INV))
#define x_in ((const float*)LDP(0))
#define c_in ((const float*)LDP(1))
#define ctx_in ((const float*)LDP(2))
#define cctx_in ((const float*)LDP(3))
#define ada_w ((const float*)LDP(4))
#define ada_b ((const float*)LDP(5))
#define norm1_g ((const float*)LDP(6))
#define norm2_g ((const float*)LDP(7))
#define router_w ((const float*)LDP(8))
#define w_gate ((const float*)LDP(9))
#define w_up ((const float*)LDP(10))
#define w_down ((const float*)LDP(11))
#define ev_w_in ((const float*)LDP(12))
#define ev_w_out ((const float*)LDP(13))
#define ev_qg ((const float*)LDP(14))
#define ev_kg ((const float*)LDP(15))
#define ev_sink ((const float*)LDP(16))
#define od_w_in ((const float*)LDP(17))
#define od_w_out ((const float*)LDP(18))
#define od_qg ((const float*)LDP(19))
#define od_kg ((const float*)LDP(20))
#define od_rpb ((const float*)LDP(21))
#define OUT ((float*)LDP(22))

#ifndef SKIP_P0
    for (int rep_ = 0; rep_ < REP_P0; ++rep_) {
    {
        { PHASE_IDS
        LAS float* scr = (LAS float*)(lds + wid * 16640);
        constexpr int I1 = 16 * 12, I2 = 256, I3 = 16 * 48, I4 = 256, I5 = 2 * 16 * 2 * 256, I6 = 2 * 16 * 256;
        constexpr int NIT = I1 + I2 + I3 + I4 + I5 + I6;
        for (int it = gw; it < NIT; it += NGW) {
            int r = it;
            if (r < I1) { const int kb = r / 12, nb = r % 12, n = nb * 64; transpose_item(ev_w_in, 1280, kb * 64, 512 + n, WQKV0, headslot_row(n), headslot_row(n + 32), scr, lane); continue; } r -= I1;
            if (r < I2) { const int kb = r / 16, nb = r % 16; transpose_item(ev_w_out, 1024, kb * 64, nb * 64, WOUT0, nb * 64, nb * 64 + 32, scr, lane); continue; } r -= I2;
            if (r < I3) { const int kb = r / 48, nb = r % 48, n = nb * 64; transpose_item(od_w_in, 3072, kb * 64, n, WIN1, headslot_row(n), headslot_row(n + 32), scr, lane); continue; } r -= I3;
            if (r < I4) { const int kb = r / 16, nb = r % 16; transpose_item(od_w_out, 1024, kb * 64, nb * 64, WOUT1, nb * 64, nb * 64 + 32, scr, lane); continue; } r -= I4;
            if (r < I5) { const int le = r >> 9, which = (r >> 8) & 1, q = r & 255, kb = q / 16, nb = q % 16, f = nb * 64;
                const float* W = (which ? w_up : w_gate) + (size_t)le * 1024 * 1024;
                const int dA = 256 * (f >> 7) + 128 * which + 32 * ((f >> 5) & 3), dB = 256 * ((f + 32) >> 7) + 128 * which + 32 * (((f + 32) >> 5) & 3);
                transpose_item(W, 1024, kb * 64, f, WGU + (size_t)le * 2048 * 1024, dA, dB, scr, lane); continue; } r -= I5;
            { const int le = r >> 8, q = r & 255, kb = q / 16, nb = q % 16;
                transpose_item(w_down + (size_t)le * 1024 * 1024, 1024, kb * 64, nb * 64, WDN + (size_t)le * 1024 * 1024, nb * 64, nb * 64 + 32, scr, lane); }
        }
        __syncthreads(); }
        { PHASE_IDS
            LAS float* tab = (LAS float*)lds;
            for (int j = tid; j < 4096; j += 512) tab[j] = cospif((float)j * (1.0f / 2048.0f));
            __syncthreads();
            for (int r = bid; r < 4096; r += G) {
                const int k = r & 2047, ph = (r >> 11) * 3072, n0 = tid * 8;
                unsigned w[4];
#pragma unroll
                for (int i = 0; i < 4; ++i) { const float v0 = tab[(k * (n0 + 2 * i) + ph) & 4095] * (1.0f / 64.0f), v1 = tab[(k * (n0 + 2 * i + 1) + ph) & 4095] * (1.0f / 64.0f); w[i] = pk2(v0, v1); }
                *(u32x4*)(DFT + (size_t)r * 4096 + n0) = (u32x4){w[0], w[1], w[2], w[3]};
            }
            for (int k = bid; k < 256; k += G) {
                const int cidx = tid; const int part = cidx >> 8, n = cidx & 255;
                const float v = tab[(((k * n) & 255) * 16 + part * 1024) & 4095] * (1.0f / 16.0f);
                DFTC[k * 512 + cidx] = (bf16_t)(pk2(v, 0.f) & 0xffffu);
            }
            for (int idx = bid * 512 + tid; idx < 4096 * 32; idx += G * 512) {
                const int t = idx >> 5, i = idx & 31; const int f = i & 15;
                const float pos = (float)(i < 16 ? (t >> 6) : (t & 63));
                const float inv_freq = powf(10000.0f, -(float)f / 16.0f);
                const float ang = pos * inv_freq;
                ROPEC[idx] = cosf(ang); ROPES[idx] = sinf(ang);
            }
            __syncthreads();
        }
        { PHASE_IDS
            LAS float* wl = (LAS float*)lds;
            LAS float* tb = wl + 32 * 129;
            for (int it = bid; it < 128; it += G) {
                const int g = it >> 5, k0 = (it & 31) * 32;
                for (int j = tid; j < 128; j += 512) tb[j] = cospif((float)j * (1.0f / 64.0f));
                for (int e = tid; e < 32 * 128; e += 512) { const int kk = e >> 7, cc = e & 127; wl[kk * 129 + cc] = ev_w_in[(size_t)(k0 + kk) * 1280 + g * 128 + cc]; }
                __syncthreads();
                const int kk = tid & 31, og = tid >> 5;
                for (int oo = 0; oo < 16; ++oo) {
                    const int o = og * 16 + oo, part = o >> 7, l = o & 127;
                    float a = 0.f;
                    for (int cc = 0; cc < 128; ++cc) a += wl[kk * 129 + cc] * tb[(l * cc - part * 32) & 127];
                    a *= 0.08838834764831845f;
                    WPR[(size_t)(part * 512 + g * 128 + l) * 1024 + k0 + kk] = (bf16_t)(pk2(a, 0.f) & 0xffffu);
                }
                __syncthreads();
            }
        }
        { PHASE_IDS
            LAS float* sv = (LAS float*)lds;
            LAS float* red = sv + 17 * 1024;
            bool loaded = false;
            for (int it = bid; it < 192; it += G) {
                if (!loaded) {
                    for (int e = tid; e < 17 * 1024; e += 512) { const int s = e >> 10, k = e & 1023; const float v = s < 16 ? c_in[s * 1024 + k] : cctx_in[k]; sv[e] = v / (1.0f + expf(-v)); }
                    loaded = true; __syncthreads();
                }
                const int l = it / 96, j0 = (it % 96) * 64;
                const int col = tid & 63, kg = tid >> 6;
                float acc[17];
#pragma unroll
                for (int s = 0; s < 17; ++s) acc[s] = 0.f;
                const float* wp = ada_w + (size_t)l * 1024 * 6144 + j0 + col;
                for (int k = kg * 128; k < kg * 128 + 128; ++k) { const float w = wp[(size_t)k * 6144];
#pragma unroll
                    for (int s = 0; s < 17; ++s) acc[s] += sv[s * 1024 + k] * w; }
#pragma unroll
                for (int s = 0; s < 17; ++s) red[(kg * 17 + s) * 64 + col] = acc[s];
                __syncthreads();
                for (int e = tid; e < 17 * 64; e += 512) { const int s = e >> 6, cc = e & 63; float a = 0.f;
#pragma unroll
                    for (int q = 0; q < 8; ++q) a += red[(q * 17 + s) * 64 + cc];
                    MOD[(size_t)(l * 17 + s) * 6144 + j0 + cc] = a + ada_b[l * 6144 + j0 + cc]; }
                __syncthreads();
            }
        }
    }
    }
#endif
    grid.sync();

    for (int layer = 0; layer < 2; ++layer) {
        const float* modl = MOD + (size_t)layer * 17 * 6144;
        const float* xin = layer == 0 ? x_in : OUT;
        const float* cin = layer == 0 ? ctx_in : CTX1;
#ifndef SKIP_N1
    if (layer == 0) {
    for (int rep_ = 0; rep_ < REP_N1; ++rep_) {
        { PHASE_IDS
            const float* gn = norm1_g + layer * 1024;
            const float* xin_ = xin; const float* cin_ = cin; const float* modp = modl; bf16_t* actv = ACTV;
            if (gw < 544) {
                const int l = gw / 272, r_ = gw % 272, s_ = r_ >> 4, e_ = r_ & 15;
                const float* shp = MOD + (size_t)(l * 17 + s_) * 6144 + 3 * 1024; const float* rwp = router_w + (size_t)l * 1024 * 16;
                float a_ = 0.f;
#pragma unroll
                for (int i = 0; i < 16; ++i) a_ += shp[lane + 64 * i] * rwp[(lane + 64 * i) * 16 + e_];
                a_ = wave_sum_fast(a_);
                if (lane == 0) CSB[(l * 17 + s_) * 16 + e_] = a_;
            }
            f32x4 vn[4];
            { const float* xr0 = gw < NX ? xin_ + (size_t)gw * D : cin_ + (size_t)(gw - NX) * D;
#pragma unroll
              for (int j = 0; j < 4; ++j) vn[j] = *(const f32x4*)(xr0 + 4 * lane + 256 * j); }
            for (int row = gw; row < NR; row += NGW) {
                const bool isx = row < NX; const int s = isx ? (row >> 12) : 16;
                const float* sh = modp + (size_t)s * 6144; const float* sc = sh + 1024;
                f32x4 v[4]; float ss = 0.f;
#pragma unroll
                for (int j = 0; j < 4; ++j) { v[j] = vn[j]; ss += (v[j][0] * v[j][0] + v[j][1] * v[j][1]) + (v[j][2] * v[j][2] + v[j][3] * v[j][3]); }
                { const int nr = row + NGW; if (nr < NR) { const float* xr1 = nr < NX ? xin_ + (size_t)nr * D : cin_ + (size_t)(nr - NX) * D;
#pragma unroll
                    for (int j = 0; j < 4; ++j) vn[j] = *(const f32x4*)(xr1 + 4 * lane + 256 * j); } }
                const float rstd = 1.0f / sqrtf(wave_sum_fast(ss) * (1.0f / 1024.0f) + 1e-6f);
#pragma unroll
                for (int j = 0; j < 4; ++j) { const int c = 4 * lane + 256 * j; const f32x4 g = *(const f32x4*)(gn + c), a = *(const f32x4*)(sc + c), bsh = *(const f32x4*)(sh + c);
                    const f32x4 h = (v[j] * rstd) * g * (a + 1.0f) + bsh;
                    u32x2 w; w.x = pk2(h[0], h[1]); w.y = pk2(h[2], h[3]); *(u32x2*)(actv + (size_t)row * D + c) = w; }
            }
        }
    }
        GRID_BAR();
    }
#endif
#ifndef SKIP_INP
    for (int rep_ = 0; rep_ < REP_INP; ++rep_) {
        if (layer == 0) {
            { pg8::Gemm g{ACTV, WPR, 1024, nullptr}; pg8::StaticOrder S; S.init(NR, 1024, G, (bid + 64) % G); EpiPR E{PRT, PRTC};
              pg8::gemm_phase<EpiPR, pg8::StaticOrder, true, false>(lds, g, S, E, wid_k); }
            { pg8::Gemm g{ACTV, WQKV0, 1024, nullptr}; pg8::StaticOrder S; S.init(NR, 768, G, bid); EpiQKV<0> E{QKV, ev_qg, ev_kg, ROPEC, ROPES};
              pg8::gemm_phase<EpiQKV<0>, pg8::StaticOrder, false, false>(lds, g, S, E, wid_k); }
        } else {
            EpiQKV<1> E{QKV, od_qg, od_kg, nullptr, nullptr};
            { pg8::Gemm g{ACTV, WIN1, 1024, nullptr}; pg8::StaticOrder S; S.init(NX, 3072, G, bid);
              pg8::gemm_phase<EpiQKV<1>, pg8::StaticOrder, false, false>(lds, g, S, E, wid_k); }
            { pg8::Gemm g{ACTV, WIN1, 1024, nullptr}; pg8::StaticOrder S; S.init(NC, 2048, G, bid, NX / 256, 4);
              pg8::gemm_phase<EpiQKV<1>, pg8::StaticOrder, false, false>(lds, g, S, E, wid_k); }
        }
    }
#endif
        GRID_BAR();
#ifndef SKIP_MIX
    for (int rep_ = 0; rep_ < REP_MIX; ++rep_) {
        if (layer == 0) {
            for (int rf_ = 0; rf_ < REP_FOUR; ++rf_)
            { pg8::Gemm g{DFT, PRT, 4096, nullptr}; FourierSched S; S.so.init(2048, 16384, G, bid); EpiUV E{UVB};
              pg8::gemm_phase<EpiUV, FourierSched, false, false>(lds, g, S, E, wid_k); }
            { pg8::Gemm g{DFTC, PRTC, 512, nullptr}; pg8::StaticOrder S; S.init(256, 8192, G, bid); EpiFourier E{ACTV, NX, LC};
              pg8::gemm_phase<EpiFourier, pg8::StaticOrder, false, false>(lds, g, S, E, wid_k); }
            __syncthreads();
            GRID_BAR();
            { PHASE_IDS
                const bf16_t* uvb = UVB; bf16_t* actv = ACTV; const bf16_t* prt = PRT;
                for (int it = gw; it < 16 * 2048; it += NGW) {
                    const int b = it >> 11, k = it & 2047;
                    const u32x4 uu = *(const u32x4*)(uvb + ((size_t)(b * 2) * 2048 + k) * 512 + 8 * lane), vv = *(const u32x4*)(uvb + ((size_t)(b * 2 + 1) * 2048 + k) * 512 + 8 * lane);
                    u32x4 ym, yp;
#pragma unroll
                    for (int q = 0; q < 4; ++q) { const float u0 = __uint_as_float(uu[q] << 16), u1 = __uint_as_float(uu[q] & 0xffff0000u), v0 = __uint_as_float(vv[q] << 16), v1 = __uint_as_float(vv[q] & 0xffff0000u);
                        ym[q] = pk2(u0 - v0, u1 - v1); yp[q] = pk2(u0 + v0, u1 + v1); }
                    *(u32x4*)(actv + ((size_t)b * SEQ + k) * D + 8 * lane) = ym;
                    if (k > 0) *(u32x4*)(actv + ((size_t)b * SEQ + (SEQ - k)) * D + 8 * lane) = yp;
                }
                for (int it = gw; it < 16 * 512; it += NGW) {
                    const int b = it >> 9, gl = it & 511;
                    const bf16_t* pr = prt + ((size_t)(b * 2) * 512 + gl) * 4096;
                    float acc = 0.f;
#pragma unroll
                    for (int i = 0; i < 8; ++i) { const u32x4 x = *(const u32x4*)(pr + (i * 64 + lane) * 8);
#pragma unroll
                        for (int q = 0; q < 4; ++q) acc += __uint_as_float(x[q] << 16) - __uint_as_float(x[q] & 0xffff0000u); }
                    acc = wave_sum_fast(acc) * (1.0f / 64.0f);
                    if (lane == 0) actv[((size_t)b * SEQ + 2048) * D + gl] = (bf16_t)(pk2(acc, 0.f) & 0xffffu);
                }
            }
            float sb0; { PHASE_IDS sb0 = score_bound(ev_qg, ev_kg, nullptr, 0, ev_sink, 8, lane); }
            for (int u = bid; u < 2048 * REP_SWA; u += G) {
                int uu = u & 2047;
                if (G == 256) { const int k_ = uu >> 8, x_ = bid & 7, m_ = bid >> 3, bk_ = m_ >> 3; uu = ((2 * k_ + (bk_ >> 1)) << 7) | ((bk_ & 1) << 6) | (8 * x_ + (m_ & 7)); }
                attn_unit<0>(uu, QKV, ACTV, ev_sink, nullptr, sb0, lds, wid_k); }
            for (int u = bid; u < 128; u += G) attn_unit<1>(u, QKV, ACTV, ev_sink, nullptr, sb0, lds, wid_k);
        } else {
            float sb1; { PHASE_IDS
                const int h_ = 2 * (bid & 7) + (bid >> 7);
                sb1 = (G == 256) ? score_bound(od_qg, od_kg, od_rpb + h_ * 465, 465, nullptr, 0, lane) : score_bound(od_qg, od_kg, od_rpb, 16 * 465, nullptr, 0, lane); }
            for (int u = bid; u < 4096 * REP_NA; u += G) {
                int uu = u & 4095;
                if (G == 256) { const int k_ = uu >> 8, m_ = bid >> 3; uu = (k_ << 8) | ((2 * (bid & 7) + (m_ >> 4)) << 4) | (m_ & 15); }
                attn_unit<2>(uu, QKV, ACTV, nullptr, od_rpb, sb1, lds, wid_k); }
        }
    }
#endif
        GRID_BAR();
#ifndef SKIP_OUTP
    for (int rep_ = 0; rep_ < REP_OUTP; ++rep_) {
        {
            pg8::Gemm g{ACTV, layer == 0 ? WOUT0 : WOUT1, 1024, nullptr}; pg8::StaticOrder S; S.init(layer == 0 ? NR : NX, 1024, G, bid);
            EpiOut E{xin, OUT, cin, CTX1, modl};
            pg8::gemm_phase<EpiOut, pg8::StaticOrder, false, false>(lds, g, S, E, wid_k);
        }
    }
#endif
        GRID_BAR();
#ifndef SKIP_N2
    for (int rep_ = 0; rep_ < REP_N2; ++rep_) {
#if N2_MFMA == 2
        { PHASE_IDS
            const int nrows = layer == 0 ? NR : NX;
            LAS float* wl = (LAS float*)lds;
            LAS float* ab = wl + 16 * 4 * 16 * 20 + wid * (16 * 68 + 16);
            LAS float* rsd = ab + 16 * 68;
            const float* rw = router_w + (size_t)layer * 1024 * 16;
            for (int e = tid; e < 1024 * 16; e += 512) { const int k = e >> 4, j = e & 15; wl[(((k >> 6) * 4 + ((k >> 4) & 3)) * 16 + j) * 20 + (k & 15)] = rw[e]; }
            __syncthreads();
            const float* gn = norm2_g + layer * 1024;
            const float* outp = OUT; const float* ctx1 = CTX1; bf16_t* actv = ACTV; float* aff = AFF; const float* modp = modl; const float* cs = CSB + layer * 272;
            const int i16 = lane & 15, kq = lane >> 4, c4 = i16 * 4;
            const int ngrp = nrows >> 4;
            for (int grp = gw; grp < ngrp; grp += NGW) {
                const int row0 = grp * 16; const bool isx = row0 < NX; const int s = isx ? (row0 >> 12) : 16;
                const float* xg = isx ? outp + (size_t)row0 * D : ctx1 + (size_t)(row0 - NX) * D;
                const float* shp = modp + (size_t)s * 6144 + 3 * 1024; const float* scp = shp + 1024;
                f32x4 acc = (f32x4){0.f, 0.f, 0.f, 0.f}; float ssq[4] = {0.f, 0.f, 0.f, 0.f};
                f32x4 xa[4], xb[4], xc[4], ga, gb, gc;
#define N2_LOAD(X, G_, c_) do { _Pragma("unroll") for (int q = 0; q < 4; ++q) X[q] = *(const f32x4*)(xg + (size_t)(4 * q + kq) * D + (c_) * 64 + c4); \
                    G_ = *(const f32x4*)(gn + (c_) * 64 + c4) * (*(const f32x4*)(scp + (c_) * 64 + c4) + 1.0f); } while (0)
#define N2_CHUNK(X, G_, c_) do { \
                    _Pragma("unroll") for (int q = 0; q < 4; ++q) { const f32x4 x4 = X[q]; ssq[q] += (x4[0] * x4[0] + x4[1] * x4[1]) + (x4[2] * x4[2] + x4[3] * x4[3]); *(LAS f32x4*)(ab + (4 * q + kq) * 68 + c4) = x4 * G_; } \
                    if ((c_) + 3 < 16) N2_LOAD(X, G_, (c_) + 3); \
                    const LAS float* ap = ab + i16 * 68 + kq * 16; const LAS float* bp = wl + (((c_) * 4 + kq) * 16 + i16) * 20; \
                    _Pragma("unroll") for (int m = 0; m < 4; ++m) { const f32x4 a4 = *(const LAS f32x4*)(ap + 4 * m), b4 = *(const LAS f32x4*)(bp + 4 * m); \
                        acc = __builtin_amdgcn_mfma_f32_16x16x4f32(a4[0], b4[0], acc, 0, 0, 0); acc = __builtin_amdgcn_mfma_f32_16x16x4f32(a4[1], b4[1], acc, 0, 0, 0); \
                        acc = __builtin_amdgcn_mfma_f32_16x16x4f32(a4[2], b4[2], acc, 0, 0, 0); acc = __builtin_amdgcn_mfma_f32_16x16x4f32(a4[3], b4[3], acc, 0, 0, 0); } \
                    asm volatile("s_waitcnt lgkmcnt(0)" ::: "memory"); } while (0)
                N2_LOAD(xa, ga, 0); N2_LOAD(xb, gb, 1); N2_LOAD(xc, gc, 2);
                for (int c = 0; c < 15; c += 3) { N2_CHUNK(xa, ga, c); N2_CHUNK(xb, gb, c + 1); N2_CHUNK(xc, gc, c + 2); }
                N2_CHUNK(xa, ga, 15);
#undef N2_LOAD
#undef N2_CHUNK
#pragma unroll
                for (int q = 0; q < 4; ++q) { const float t_ = row16_sum(ssq[q]); if (i16 == 0) rsd[4 * q + kq] = 1.0f / sqrtf(t_ * (1.0f / 1024.0f) + 1e-6f); }
                asm volatile("s_waitcnt lgkmcnt(0)" ::: "memory");
                const float cse = cs[s * 16 + i16];
#pragma unroll
                for (int r = 0; r < 4; ++r) {
                    const float lgt = rsd[4 * kq + r] * acc[r] + cse;
                    const float mx = row16_max(lgt), ex = expf(lgt - mx), sm = row16_sum(ex);
                    aff[(size_t)(row0 + 4 * kq + r) * 16 + i16] = ex / sm;
                }
                float rs4[4];
#pragma unroll
                for (int q = 0; q < 4; ++q) rs4[q] = rsd[4 * q + kq];
#pragma unroll 4
                for (int c = 0; c < 16; ++c) {
                    const int col = c * 64 + c4; const f32x4 g4 = *(const f32x4*)(gn + col), a4 = *(const f32x4*)(scp + col) + 1.0f, b4 = *(const f32x4*)(shp + col);
#pragma unroll
                    for (int q = 0; q < 4; ++q) { const f32x4 x4 = *(const f32x4*)(xg + (size_t)(4 * q + kq) * D + col);
                        const f32x4 h = (x4 * rs4[q]) * g4 * a4 + b4; u32x2 w; w.x = pk2(h[0], h[1]); w.y = pk2(h[2], h[3]); *(u32x2*)(actv + (size_t)(row0 + 4 * q + kq) * D + col) = w; }
                }
                asm volatile("s_waitcnt lgkmcnt(0)" ::: "memory");
            }
        }
#elif N2_MFMA
        { PHASE_IDS
            const int nrows = layer == 0 ? NR : NX;
            LAS float* wl = (LAS float*)lds;
            const float* rw = router_w + (size_t)layer * 1024 * 16;
            for (int e = tid; e < 1024 * 16; e += 512) { const int k = e >> 4, j = e & 15; wl[((k >> 8) * 16 + j) * 260 + (k & 255)] = rw[e]; }
            __syncthreads();
            const float* gn = norm2_g + layer * 1024;
            const float* outp = OUT; const float* ctx1 = CTX1; bf16_t* actv = ACTV; float* aff = AFF; const float* modp = modl; const float* cs = CSB + layer * 272;
            const int i16 = lane & 15, kq = lane >> 4;
            const LAS float* wb = wl + (kq * 16 + i16) * 260;
            const int ngrp = nrows >> 4;
            for (int grp = gw; grp < ngrp; grp += NGW) {
                const int row0 = grp * 16; const bool isx = row0 < NX; const int s = isx ? (row0 >> 12) : 16;
                const float* xr = (isx ? outp + (size_t)row0 * D : ctx1 + (size_t)(row0 - NX) * D) + (size_t)i16 * D + kq * 256;
                const float* shp = modp + (size_t)s * 6144 + 3 * 1024 + kq * 256; const float* scp = shp + 1024; const float* gp = gn + kq * 256;
                f32x4 acc = (f32x4){0.f, 0.f, 0.f, 0.f}; float ss = 0.f;
#pragma unroll 4
                for (int c = 0; c < 64; ++c) {
                    const f32x4 x4 = *(const f32x4*)(xr + 4 * c), g4 = *(const f32x4*)(gp + 4 * c), a4 = *(const f32x4*)(scp + 4 * c);
                    const f32x4 w4 = *(const LAS f32x4*)(wb + 4 * c);
                    ss += (x4[0] * x4[0] + x4[1] * x4[1]) + (x4[2] * x4[2] + x4[3] * x4[3]);
                    const f32x4 u4 = (x4 * g4) * (a4 + 1.0f);
                    acc = __builtin_amdgcn_mfma_f32_16x16x4f32(u4[0], w4[0], acc, 0, 0, 0);
                    acc = __builtin_amdgcn_mfma_f32_16x16x4f32(u4[1], w4[1], acc, 0, 0, 0);
                    acc = __builtin_amdgcn_mfma_f32_16x16x4f32(u4[2], w4[2], acc, 0, 0, 0);
                    acc = __builtin_amdgcn_mfma_f32_16x16x4f32(u4[3], w4[3], acc, 0, 0, 0);
                }
                ss = xrow_sum(ss);
                const float rstd = 1.0f / sqrtf(ss * (1.0f / 1024.0f) + 1e-6f);
                const float cse = cs[s * 16 + i16];
#pragma unroll
                for (int r = 0; r < 4; ++r) {
                    const float rr = __int_as_float(__builtin_amdgcn_ds_bpermute((4 * kq + r) << 2, __float_as_int(rstd)));
                    const float lgt = rr * acc[r] + cse;
                    const float mx = row16_max(lgt), ex = expf(lgt - mx), sm = row16_sum(ex);
                    aff[(size_t)(row0 + 4 * kq + r) * 16 + i16] = ex / sm;
                }
                bf16_t* hp = actv + (size_t)(row0 + i16) * D + kq * 256;
#pragma unroll 2
                for (int c = 0; c < 32; ++c) {
                    unsigned w[4];
#pragma unroll
                    for (int q = 0; q < 2; ++q) { const int o = 8 * c + 4 * q; const f32x4 x4 = *(const f32x4*)(xr + o), g4 = *(const f32x4*)(gp + o), a4 = *(const f32x4*)(scp + o), b4 = *(const f32x4*)(shp + o);
                        const f32x4 h = (x4 * rstd) * g4 * (a4 + 1.0f) + b4; w[2 * q] = pk2(h[0], h[1]); w[2 * q + 1] = pk2(h[2], h[3]); }
                    *(u32x4*)(hp + 8 * c) = (u32x4){w[0], w[1], w[2], w[3]};
                }
            }
        }
#else
        { PHASE_IDS
            const int nrows = layer == 0 ? NR : NX;
            LAS f32x4* wl = (LAS f32x4*)lds;
            const float* rw = router_w + (size_t)layer * 1024 * 16;
            for (int e = tid; e < 1024 * 4; e += 512) { const int col = e >> 2, e4 = e & 3; const int c = col & 3, ln = (col >> 2) & 63, j = col >> 8;
                wl[((c * 4 + j) * 4 + e4) * 64 + ln] = *(const f32x4*)(rw + col * 16 + e4 * 4); }
            __syncthreads();
            const float* gn = norm2_g + layer * 1024;
            const float* outp = OUT; const float* ctx1 = CTX1; bf16_t* actv = ACTV; float* aff = AFF; const float* modp = modl;
            f32x4 vn[4];
#pragma unroll
            for (int j = 0; j < 4; ++j) vn[j] = (f32x4){0.f, 0.f, 0.f, 0.f};
            for (int row = gw; row < nrows; row += NGW) {
                const bool isx = row < NX; const int s = isx ? (row >> 12) : 16;
                if (row == gw) { const float* xr0 = isx ? outp + (size_t)row * D : ctx1 + (size_t)(row - NX) * D;
#pragma unroll
                    for (int j = 0; j < 4; ++j) vn[j] = *(const f32x4*)(xr0 + 4 * lane + 256 * j); }
                const float* sh = modp + (size_t)s * 6144 + 3 * 1024; const float* sc = sh + 1024;
                f32x4 v[4]; float ss = 0.f;
#pragma unroll
                for (int j = 0; j < 4; ++j) { v[j] = vn[j]; ss += (v[j][0] * v[j][0] + v[j][1] * v[j][1]) + (v[j][2] * v[j][2] + v[j][3] * v[j][3]); }
                const float rstd = 1.0f / sqrtf(wave_sum_fast(ss) * (1.0f / 1024.0f) + 1e-6f);
                f32x2_t lg2[8];
#pragma unroll
                for (int e = 0; e < 8; ++e) lg2[e] = (f32x2_t){0.f, 0.f};
#pragma unroll
                for (int j = 0; j < 4; ++j) { const int c = 4 * lane + 256 * j; const f32x4 g = *(const f32x4*)(gn + c), a = *(const f32x4*)(sc + c), bsh = *(const f32x4*)(sh + c);
                    const f32x4 h = (v[j] * rstd) * g * (a + 1.0f) + bsh;
                    u32x2 w; w.x = pk2(h[0], h[1]); w.y = pk2(h[2], h[3]); *(u32x2*)(actv + (size_t)row * D + c) = w;
#pragma unroll
                    for (int cc = 0; cc < 4; ++cc) { const f32x2_t hh = (f32x2_t){h[cc], h[cc]};
#pragma unroll
                        for (int e4 = 0; e4 < 4; ++e4) { const f32x4 w4 = wl[((cc * 4 + j) * 4 + e4) * 64 + lane];
                            lg2[e4 * 2 + 0] = __builtin_elementwise_fma(hh, (f32x2_t){w4[0], w4[1]}, lg2[e4 * 2 + 0]); lg2[e4 * 2 + 1] = __builtin_elementwise_fma(hh, (f32x2_t){w4[2], w4[3]}, lg2[e4 * 2 + 1]);
                            if (e4 == 3 && (cc & 1)) asm volatile("" ::: "memory"); } }
                    if (j == 1) { const int nr = row + NGW; if (nr < nrows) { const float* xr1 = nr < NX ? outp + (size_t)nr * D : ctx1 + (size_t)(nr - NX) * D;
#pragma unroll
                        for (int q = 0; q < 4; ++q) vn[q] = *(const f32x4*)(xr1 + 4 * lane + 256 * q); } }
                }
                float lg[16];
#pragma unroll
                for (int e = 0; e < 8; ++e) { lg[2 * e] = lg2[e][0]; lg[2 * e + 1] = lg2[e][1]; }
                router_softmax_store(lg, lane, aff + (size_t)row * 16, true);
            }
        }
#endif
    }
#endif
        GRID_BAR();
#ifndef SKIP_TOPK
    for (int rep_ = 0; rep_ < REP_TOPK; ++rep_) {
        { PHASE_IDS
            LAS int* cnt = (LAS int*)lds;
            LAS int* wsum = cnt + 64;
            const int nprob = layer == 0 ? 512 : 256;
            for (int pr = bid; pr < nprob; pr += G) {
                const bool isx = pr < 256; const int q = pr & 255, b = q >> 4, e = q & 15;
                const int n = isx ? SEQ : LC, kk = isx ? CAPX : CAPC;
                const int rowbase = isx ? b * SEQ : NX + b * LC;
                const int slotbase = isx ? (e * 16 + b) * CAPX : NSLOT_X + (e * 16 + b) * CAPC;
                if (tid < 40) cnt[tid] = 0;
                unsigned key[8]; bool valid[8];
#pragma unroll
                for (int i = 0; i < 8; ++i) { const int t = tid * 8 + i; valid[i] = t < n; key[i] = valid[i] ? __float_as_uint(AFF[(size_t)(rowbase + t) * 16 + e]) : 0u; }
                __syncthreads();
                unsigned T = 0u;
                for (int bit = 30; bit >= 0; --bit) {
                    const unsigned cand = T | (1u << bit);
                    int c = 0;
#pragma unroll
                    for (int i = 0; i < 8; ++i) c += __builtin_popcountll(__ballot(valid[i] && key[i] >= cand));
                    if (lane == 0 && c) __hip_atomic_fetch_add(&cnt[bit], c, __ATOMIC_RELAXED, __HIP_MEMORY_SCOPE_WORKGROUP);
                    __syncthreads();
                    if (cnt[bit] >= kk) T = cand;
                }
                int ngt = 0, neq = 0;
#pragma unroll
                for (int i = 0; i < 8; ++i) { ngt += (valid[i] && key[i] > T) ? 1 : 0; neq += (valid[i] && key[i] == T) ? 1 : 0; }
                int tot_gt, tot_eq;
                (void)block_excl_scan(ngt, wsum, lane, wid, tot_gt);
                const int eqpre = block_excl_scan(neq, wsum, lane, wid, tot_eq);
                const int need = kk - tot_gt;
                bool take[8]; int ntake = 0, er = eqpre;
#pragma unroll
                for (int i = 0; i < 8; ++i) { const bool gt = valid[i] && key[i] > T, eq = valid[i] && key[i] == T; take[i] = gt || (eq && er < need); er += eq ? 1 : 0; ntake += take[i] ? 1 : 0; }
                int tot_take;
                int pos = block_excl_scan(ntake, wsum, lane, wid, tot_take);
#pragma unroll
                for (int i = 0; i < 8; ++i) { if (valid[i]) INV[(size_t)(rowbase + tid * 8 + i) * 16 + e] = take[i] ? slotbase + pos : -1;
                    if (take[i]) { ROWIDX[slotbase + pos] = rowbase + tid * 8 + i; GATEV[slotbase + pos] = __uint_as_float(key[i]); ++pos; } }
                __syncthreads();
            }
        }
    }
#endif
        GRID_BAR();
#ifndef SKIP_MOE
    for (int rep_ = 0; rep_ < REP_MOE; ++rep_) {
        {
            bf16_t* actp = ACT + (size_t)bid * 256 * 1024;
            const int nx = (512 - bid + G - 1) / G;
            const int ncg = layer == 0 ? (256 - bid + G - 1) / G : 0;
            const int ncd = layer == 0 && bid < 128 ? (128 - bid + G - 1) / G : 0;
            for (int it = 0; it < ncg + nx + ncd; ++it) {
                const bool isgu = it < ncg, isdn = it >= ncg + nx, isx = !isgu && !isdn;
                int e, c = 0, pn0 = 0; const int* gather; bf16_t* abuf; int slot0, ngu = 8, ndn = 4;
                if (isx) { const int kx = it - ncg; const int tile = (G == 256) ? (((bid & 7) + 8 * kx) * 32 + (bid >> 3)) : (bid + kx * G); e = tile >> 5;
                    gather = ROWIDX + tile * 256; abuf = actp; slot0 = tile * 256; }
                else { const int u = bid + (isgu ? it : it - ncg - nx) * G; if (G == 256) { const int x_ = u & 7, m_ = u >> 3; c = isgu ? (4 * x_ + (m_ >> 3)) : (4 * x_ + (m_ >> 2)); pn0 = isgu ? (m_ & 7) : (m_ & 3); }
                    else { c = isgu ? (u >> 3) : (u >> 2); pn0 = isgu ? (u & 7) : (u & 3); }
                    e = c >> 1;
                    gather = ROWIDX + (512 + c) * 256; abuf = ACTC + (size_t)c * 256 * 1024; slot0 = (512 + c) * 256; ngu = 1; ndn = 1; }
                const int le = layer * 16 + e;
                if (!isdn) {
                    pg8::Gemm g{ACTV, WGU + (size_t)le * 2048 * 1024, 1024, gather}; pg8::TileSched S{0, pn0, ngu}; EpiGU E{abuf};
                    pg8::gemm_phase<EpiGU, pg8::TileSched, false, true>(lds, g, S, E, wid_k);
                    asm volatile("s_waitcnt vmcnt(0)" ::: "memory");
                    __syncthreads();
                    if (isgu) { if (threadIdx.x == 0) { __builtin_amdgcn_fence(__ATOMIC_RELEASE, "agent"); asm volatile("s_waitcnt vmcnt(0)" ::: "memory");
                                    __hip_atomic_fetch_add(CNTW + c, 1, __ATOMIC_RELAXED, __HIP_MEMORY_SCOPE_AGENT); } }
                }
                if (!isgu) {
                    if (isdn) { if (threadIdx.x == 0) { int* cw = CNTW + c; while (__hip_atomic_load(cw, __ATOMIC_RELAXED, __HIP_MEMORY_SCOPE_AGENT) < 8) __builtin_amdgcn_s_sleep(8); }
                                __syncthreads(); }
                    __builtin_amdgcn_fence(__ATOMIC_ACQUIRE, "agent");
                    pg8::Gemm g{abuf, WDN + (size_t)le * 1024 * 1024, 1024, nullptr}; pg8::TileSched S{0, pn0, ndn}; EpiDown E{YB, slot0};
                    pg8::gemm_phase<EpiDown, pg8::TileSched, false, false>(lds, g, S, E, wid_k);
                    __syncthreads();
                }
            }
        }
    }
#endif
        GRID_BAR();
        { PHASE_IDS
            const int nrows = layer == 0 ? NR : NX;
            const int* inv = INV; const float* gatev = GATEV; const bf16_t* yb = YB; float* outp = OUT; float* ctx1 = CTX1;
            const float* gn1 = norm1_g + 1024; const float* modn = MOD + (size_t)17 * 6144; bf16_t* actv = ACTV; const float* modp2 = modl;
            int inv_n = (lane < 16 && gw < nrows) ? inv[(size_t)gw * 16 + lane] : -1;
            for (int row = gw; row < nrows; row += NGW) {
                const bool isx = row < NX; const int s = isx ? (row >> 12) : 16;
                const int myinv = inv_n;
                { const int nr = row + NGW; inv_n = (lane < 16 && nr < nrows) ? inv[(size_t)nr * 16 + lane] : -1; }
                float* xr = isx ? outp + (size_t)row * D : ctx1 + (size_t)(row - NX) * D;
                f32x4 xv4[4];
#pragma unroll
                for (int hh = 0; hh < 2; ++hh)
#pragma unroll
                    for (int q = 0; q < 2; ++q) xv4[hh * 2 + q] = *(const f32x4*)(xr + hh * 512 + 8 * lane + 4 * q);
                float acc[16];
#pragma unroll
                for (int i = 0; i < 16; ++i) acc[i] = 0.f;
                unsigned emask = (unsigned)(__ballot(myinv >= 0) & 0xffffull);
                while (emask) {
                    const int e0 = __builtin_ctz(emask); emask &= emask - 1u;
                    const bool two = emask != 0u; const int e1 = two ? __builtin_ctz(emask) : e0; if (two) emask &= emask - 1u;
                    const int s0 = __builtin_amdgcn_readlane(myinv, e0), s1 = __builtin_amdgcn_readlane(myinv, e1);
                    const float g0 = gatev[s0], g1r = gatev[s1];
                    const u32x4 y0 = *(const u32x4*)(yb + (size_t)s0 * D + 8 * lane), y1 = *(const u32x4*)(yb + (size_t)s0 * D + 512 + 8 * lane);
                    const u32x4 z0 = *(const u32x4*)(yb + (size_t)s1 * D + 8 * lane), z1 = *(const u32x4*)(yb + (size_t)s1 * D + 512 + 8 * lane);
                    const float g1 = two ? g1r : 0.f;
#pragma unroll
                    for (int q = 0; q < 4; ++q) { acc[2 * q] += g0 * __uint_as_float(y0[q] << 16); acc[2 * q + 1] += g0 * __uint_as_float(y0[q] & 0xffff0000u);
                        acc[8 + 2 * q] += g0 * __uint_as_float(y1[q] << 16); acc[8 + 2 * q + 1] += g0 * __uint_as_float(y1[q] & 0xffff0000u); }
#pragma unroll
                    for (int q = 0; q < 4; ++q) { acc[2 * q] += g1 * __uint_as_float(z0[q] << 16); acc[2 * q + 1] += g1 * __uint_as_float(z0[q] & 0xffff0000u);
                        acc[8 + 2 * q] += g1 * __uint_as_float(z1[q] << 16); acc[8 + 2 * q + 1] += g1 * __uint_as_float(z1[q] & 0xffff0000u); }
                }
                const float* g2 = modp2 + (size_t)s * 6144 + 5 * 1024;
#pragma unroll
                for (int hh = 0; hh < 2; ++hh)
#pragma unroll
                    for (int q = 0; q < 2; ++q) { const int c = hh * 512 + 8 * lane + 4 * q; const f32x4 xv = xv4[hh * 2 + q], gv = *(const f32x4*)(g2 + c);
                        f32x4 a; a[0] = acc[hh * 8 + 4 * q]; a[1] = acc[hh * 8 + 4 * q + 1]; a[2] = acc[hh * 8 + 4 * q + 2]; a[3] = acc[hh * 8 + 4 * q + 3];
                        const f32x4 nx_ = xv + gv * a; *(f32x4*)(xr + c) = nx_;
                        acc[hh * 8 + 4 * q] = nx_[0]; acc[hh * 8 + 4 * q + 1] = nx_[1]; acc[hh * 8 + 4 * q + 2] = nx_[2]; acc[hh * 8 + 4 * q + 3] = nx_[3]; }
                if (layer == 0) {
                    float ss = 0.f;
#pragma unroll
                    for (int i = 0; i < 16; ++i) ss += acc[i] * acc[i];
                    const float rstd = 1.0f / sqrtf(wave_sum_fast(ss) * (1.0f / 1024.0f) + 1e-6f);
                    const float* sh1 = modn + (size_t)s * 6144; const float* sc1 = sh1 + 1024;
#pragma unroll
                    for (int hh = 0; hh < 2; ++hh) { const int c = hh * 512 + 8 * lane; unsigned w[4];
#pragma unroll
                        for (int q = 0; q < 2; ++q) { const f32x4 g = *(const f32x4*)(gn1 + c + 4 * q), a = *(const f32x4*)(sc1 + c + 4 * q), bsh = *(const f32x4*)(sh1 + c + 4 * q);
                            f32x4 xv; xv[0] = acc[hh * 8 + 4 * q]; xv[1] = acc[hh * 8 + 4 * q + 1]; xv[2] = acc[hh * 8 + 4 * q + 2]; xv[3] = acc[hh * 8 + 4 * q + 3];
                            const f32x4 h = (xv * rstd) * g * (a + 1.0f) + bsh; w[2 * q] = pk2(h[0], h[1]); w[2 * q + 1] = pk2(h[2], h[3]); }
                        *(u32x4*)(actv + (size_t)row * D + c) = (u32x4){w[0], w[1], w[2], w[3]}; }
                }
            }
        }
        GRID_BAR();
    }
    for (int i = 0; i < EXTRA_SYNCS; ++i) GRID_BAR();
}

extern "C" void kernel_launch(void* const* d_in, const int* in_sizes, int n_in, void* d_out, int out_size, void* d_ws, size_t ws_size, hipStream_t stream) {
    static int grid = 0;
    if (grid == 0) {
        if (n_in != 22 || out_size != NX * D || ws_size < WS_END) { fprintf(stderr, "kernel_launch: unexpected shapes (n_in %d out %d ws %zu need %zu)\n", n_in, out_size, ws_size, (size_t)WS_END); grid = -1; return; }
        int dev = 0, cus = 0, per_cu = 0;
        (void)hipGetDevice(&dev);
        (void)hipDeviceGetAttribute(&cus, hipDeviceAttributeMultiprocessorCount, dev);
        if (hipFuncSetAttribute((const void*)fwd_kernel, hipFuncAttributeMaxDynamicSharedMemorySize, LDS_BYTES) != hipSuccess) { fprintf(stderr, "kernel_launch: hipFuncSetAttribute failed\n"); grid = -1; return; }
        (void)hipOccupancyMaxActiveBlocksPerMultiprocessor(&per_cu, (const void*)fwd_kernel, 512, LDS_BYTES);
        if (per_cu < 1) { fprintf(stderr, "kernel_launch: occupancy query says %d blocks per CU\n", per_cu); per_cu = 1; }
        (void)hipGetLastError();
        grid = cus * per_cu; if (grid > 256) grid = 256;
    }
    if (grid < 0) return;
    if (hipMemsetAsync((char*)d_ws + WS_CNT, 0, 64 * 1024, stream) != hipSuccess) { fprintf(stderr, "kernel_launch: memset of control words failed\n"); return; }
    Params p{};
    for (int i = 0; i < 22; ++i) p.in[i] = (const float*)d_in[i];
    p.out = (float*)d_out; p.ws = (unsigned char*)d_ws;
    void* args[] = {&p};
    hipError_t e = hipLaunchCooperativeKernel((const void*)fwd_kernel, dim3(grid), dim3(512), args, LDS_BYTES, stream);
    if (e != hipSuccess) fprintf(stderr, "cooperative launch failed: %s (grid %d)\n", hipGetErrorString(e), grid);
}
```
